# Optimizing an MI355X kernel written in HIP

```python
import jax
import jax.numpy as jnp
from jax import lax
import numpy as np

D_MODEL = 2048
BATCH = 16
SEQ = 2048
DEPTH = 1
DEC_BATCH = 128
DEC_SEQ = 1
PAST_LEN = 16384
PAGE_SIZE = 128

HEAD_DIM = 64
N_HEADS = 16
N_KV_HEADS = 4
GROUP = N_HEADS // N_KV_HEADS
WINDOW = 128
BLOCK = WINDOW
ROT_DIM = HEAD_DIM // 4
ROPE_THETA = 500000.0
ATTN_SCALE = HEAD_DIM ** -0.5
Q_DIM = N_HEADS * HEAD_DIM
KV_DIM = N_KV_HEADS * HEAD_DIM
CONV_CH = D_MODEL - Q_DIM
CONV_W = 31
MIX_WIDTH = Q_DIM + CONV_CH
IN_DIM = Q_DIM + 2 * KV_DIM + 2 * CONV_CH
D_FF = 4 * D_MODEL
EPS = 1e-5

kernel_name = 'hymba_swa_sink_conformer_conv_sqrelu_step'


def _rms_norm(x, g):
    xf = x.astype(jnp.float32)
    y = xf * lax.rsqrt(jnp.mean(xf * xf, axis=-1, keepdims=True) + EPS)
    return (y * g.astype(jnp.float32)).astype(x.dtype)


def _partial_rope(x, pos):
    half = ROT_DIM // 2
    inv_freq = jnp.power(jnp.float32(ROPE_THETA), -jnp.arange(half, dtype=jnp.float32) * 2.0 / ROT_DIM)
    ang = pos.astype(jnp.float32)[:, None] * inv_freq[None, :]
    cos = jnp.cos(ang)[None, :, None, :]
    sin = jnp.sin(ang)[None, :, None, :]
    xr = x[..., :ROT_DIM].astype(jnp.float32)
    x1, x2 = xr[..., :half], xr[..., half:]
    rot = jnp.concatenate([x1 * cos - x2 * sin, x2 * cos + x1 * sin], axis=-1).astype(x.dtype)
    return jnp.concatenate([rot, x[..., ROT_DIM:]], axis=-1)


def _project_in(hn, w_in, b_in, pos):
    n, t, _ = hn.shape
    z = hn @ w_in + b_in
    o1, o2, o3, o4 = Q_DIM, Q_DIM + KV_DIM, Q_DIM + 2 * KV_DIM, Q_DIM + 2 * KV_DIM + CONV_CH
    q = z[..., :o1].reshape(n, t, N_HEADS, HEAD_DIM)
    k = z[..., o1:o2].reshape(n, t, N_KV_HEADS, HEAD_DIM)
    v = z[..., o2:o3].reshape(n, t, N_KV_HEADS, HEAD_DIM)
    u = z[..., o3:o4] * jax.nn.sigmoid(z[..., o4:])
    return _partial_rope(q, pos), _partial_rope(k, pos), v, u


def _sink_softmax(s, mask, sink):
    s = jnp.where(mask, s, -jnp.inf)
    m = jnp.maximum(jnp.max(s, axis=-1, keepdims=True), sink)
    p = jnp.exp(s - m)
    return p / (jnp.sum(p, axis=-1, keepdims=True) + jnp.exp(sink - m))


def _banded_window_attention(q, k, v, sinks):
    n, t = q.shape[:2]
    nb = t // BLOCK
    qb = q.reshape(n, nb, BLOCK, N_KV_HEADS, GROUP, HEAD_DIM)
    kb = k.reshape(n, nb, BLOCK, N_KV_HEADS, HEAD_DIM)
    vb = v.reshape(n, nb, BLOCK, N_KV_HEADS, HEAD_DIM)

    def with_prev(xb):
        prev = jnp.concatenate([jnp.zeros_like(xb[:, :1]), xb[:, :-1]], axis=1)
        return jnp.concatenate([prev, xb], axis=2)

    kk, vv = with_prev(kb), with_prev(vb)
    s = jnp.einsum('bnqhgd,bnshd->bnhgqs', qb, kk, preferred_element_type=jnp.float32) * ATTN_SCALE
    i = jnp.arange(BLOCK)[:, None]
    j = jnp.arange(2 * BLOCK)[None, :]
    rel = i + BLOCK - j
    band = (rel >= 0) & (rel < WINDOW)
    has_prev = (jnp.arange(nb) > 0)[:, None, None] | (j >= BLOCK)[None]
    mask = (band[None] & has_prev)[None, :, None, None]
    sink = sinks.astype(jnp.float32).reshape(1, 1, N_KV_HEADS, GROUP, 1, 1)
    p = _sink_softmax(s, mask, sink)
    o = jnp.einsum('bnhgqs,bnshd->bnqhgd', p.astype(v.dtype), vv)
    return o.reshape(n, t, Q_DIM)


def _window_cache_attention(q, k, v, buf_k, buf_v, sinks):
    n, t = q.shape[:2]
    wb = buf_k.shape[1]
    kk = jnp.concatenate([buf_k.astype(k.dtype), k], axis=1)
    vv = jnp.concatenate([buf_v.astype(v.dtype), v], axis=1)
    qg = q.reshape(n, t, N_KV_HEADS, GROUP, HEAD_DIM)
    s = jnp.einsum('bqhgd,bshd->bhgqs', qg, kk, preferred_element_type=jnp.float32) * ATTN_SCALE
    q_pos = PAST_LEN + jnp.arange(t)
    k_pos = PAST_LEN - wb + jnp.arange(wb + t)
    rel = q_pos[:, None] - k_pos[None, :]
    mask = ((rel >= 0) & (rel < WINDOW))[None, None, None]
    sink = sinks.astype(jnp.float32).reshape(1, N_KV_HEADS, GROUP, 1, 1)
    p = _sink_softmax(s, mask, sink)
    o = jnp.einsum('bhgqs,bshd->bqhgd', p.astype(vv.dtype), vv)
    return o.reshape(n, t, Q_DIM), kk[:, -wb:], vv[:, -wb:]


def _conv_branch(u_ext, conv_w, conv_b, ln_g, ln_b):
    y = lax.conv_general_dilated(
        u_ext, conv_w[:, None, :].astype(u_ext.dtype), window_strides=(1,), padding='VALID',
        dimension_numbers=('NWC', 'WIO', 'NWC'), feature_group_count=u_ext.shape[-1])
    y = (y + conv_b).astype(jnp.float32)
    mu = jnp.mean(y, axis=-1, keepdims=True)
    yc = y - mu
    var = jnp.mean(yc * yc, axis=-1, keepdims=True)
    yn = yc * lax.rsqrt(var + EPS) * ln_g.astype(jnp.float32) + ln_b.astype(jnp.float32)
    return (yn * jax.nn.sigmoid(yn)).astype(u_ext.dtype)


def _merge_and_mlp(h, attn_o, conv_o, w_out, b_out, norm2_g, w_up, w_down):
    h = h + jnp.concatenate([attn_o, conv_o], axis=-1) @ w_out + b_out
    hn = _rms_norm(h, norm2_g)
    return h + jnp.square(jax.nn.relu(hn @ w_up)) @ w_down


def setup_inputs(seed: int = 0) -> dict:
    key = jax.random.key(seed)
    ks = jax.random.split(key, 20)
    f32 = jnp.float32
    wb = min(WINDOW, PAST_LEN)
    nrm = lambda k, shape, scale: jax.random.normal(k, shape, f32) * scale
    return {
        'x_prompt': nrm(ks[0], (BATCH, SEQ, D_MODEL), 1.0),
        'x_sample': nrm(ks[1], (DEC_BATCH, DEC_SEQ, D_MODEL), 1.0),
        'cache_k': nrm(ks[2], (DEPTH, DEC_BATCH, wb, N_KV_HEADS, HEAD_DIM), 1.0),
        'cache_v': nrm(ks[3], (DEPTH, DEC_BATCH, wb, N_KV_HEADS, HEAD_DIM), 1.0),
        'cache_conv': nrm(ks[4], (DEPTH, DEC_BATCH, CONV_W - 1, CONV_CH), 0.5),
        'norm1_g': 1.0 + nrm(ks[5], (DEPTH, D_MODEL), 0.02),
        'w_in': nrm(ks[6], (DEPTH, D_MODEL, IN_DIM), D_MODEL ** -0.5),
        'b_in': nrm(ks[7], (DEPTH, IN_DIM), 0.02),
        'attn_sinks': nrm(ks[8], (DEPTH, N_HEADS), 0.5),
        'conv_w': nrm(ks[9], (DEPTH, CONV_W, CONV_CH), CONV_W ** -0.5),
        'conv_b': nrm(ks[10], (DEPTH, CONV_CH), 0.02),
        'conv_ln_g': 1.0 + nrm(ks[11], (DEPTH, CONV_CH), 0.02),
        'conv_ln_b': nrm(ks[12], (DEPTH, CONV_CH), 0.02),
        'w_out': nrm(ks[13], (DEPTH, MIX_WIDTH, D_MODEL), MIX_WIDTH ** -0.5),
        'b_out': nrm(ks[14], (DEPTH, D_MODEL), 0.02),
        'norm2_g': 1.0 + nrm(ks[15], (DEPTH, D_MODEL), 0.02),
        'w_up': nrm(ks[16], (DEPTH, D_MODEL, D_FF), D_MODEL ** -0.5),
        'w_down': nrm(ks[17], (DEPTH, D_FF, D_MODEL), D_FF ** -0.5),
        'final_norm_g': 1.0 + nrm(ks[18], (D_MODEL,), 0.02),
    }


def reference(x_prompt, x_sample, cache_k, cache_v, cache_conv, norm1_g, w_in, b_in, attn_sinks,
              conv_w, conv_b, conv_ln_g, conv_ln_b, w_out, b_out, norm2_g, w_up, w_down, final_norm_g):
    t_p = x_prompt.shape[1]
    t_s = x_sample.shape[1]
    pos_p = jnp.arange(t_p, dtype=jnp.int32)
    pos_s = PAST_LEN + jnp.arange(t_s, dtype=jnp.int32)
    wp = min(WINDOW, t_p)
    hp, hs = x_prompt, x_sample
    pk, pv, pc, sk, sv, sc = [], [], [], [], [], []
    for l in range(DEPTH):
        q, k, v, u = _project_in(_rms_norm(hp, norm1_g[l]), w_in[l], b_in[l], pos_p)
        a_o = _banded_window_attention(q, k, v, attn_sinks[l])
        c_o = _conv_branch(jnp.pad(u, ((0, 0), (CONV_W - 1, 0), (0, 0))),
                           conv_w[l], conv_b[l], conv_ln_g[l], conv_ln_b[l])
        hp = _merge_and_mlp(hp, a_o, c_o, w_out[l], b_out[l], norm2_g[l], w_up[l], w_down[l])
        pk.append(k[:, -wp:])
        pv.append(v[:, -wp:])
        pc.append(u[:, -(CONV_W - 1):])
        q, k, v, u = _project_in(_rms_norm(hs, norm1_g[l]), w_in[l], b_in[l], pos_s)
        a_o, nk, nv = _window_cache_attention(q, k, v, cache_k[l], cache_v[l], attn_sinks[l])
        u_ext = jnp.concatenate([cache_conv[l].astype(u.dtype), u], axis=1)
        c_o = _conv_branch(u_ext, conv_w[l], conv_b[l], conv_ln_g[l], conv_ln_b[l])
        hs = _merge_and_mlp(hs, a_o, c_o, w_out[l], b_out[l], norm2_g[l], w_up[l], w_down[l])
        sk.append(nk)
        sv.append(nv)
        sc.append(u_ext[:, -(CONV_W - 1):])
    y_prompt = _rms_norm(hp, final_norm_g)
    y_sample = _rms_norm(hs, final_norm_g)
    return (y_prompt, y_sample, jnp.stack(pk), jnp.stack(pv), jnp.stack(pc),
            jnp.stack(sk), jnp.stack(sv), jnp.stack(sc))
```

```cpp
#include <hip/hip_runtime.h>
#include <hip/hip_cooperative_groups.h>
#include <cstdio>
#include <cstdint>
namespace cg = cooperative_groups;

#ifndef MK_LAUNCHES
#define MK_LAUNCHES 1
#endif

constexpr int DM = 2048, NBATCH = 16, SEQ = 2048, MP = NBATCH * SEQ, MS = 128, MR = MP + MS, RPAD = 33024;
constexpr int QD = 1024, KVD = 256, CCH = 1024, IN_DIM = 3584, DFF = 8192, CONVW = 31;
constexpr float EPS = 1e-5f;
constexpr float C2 = 0.125f * 1.4426950408889634f;
constexpr float LOG2E = 1.4426950408889634f;
constexpr size_t O_Y = 0, O_PK = 67371008, O_PV = 67895296, O_PC = 68419584, O_SK = 68911104, O_SV = 73105408, O_SC = 77299712;
constexpr size_t MiB = 1u << 20;
constexpr size_t WS_WIN = 0, WS_WOUT = 14 * MiB, WS_WUP = 22 * MiB, WS_WDN = 54 * MiB;
constexpr size_t WS_ROPE = 86 * MiB, WS_BPERM = 86 * MiB + 256 * 1024, WS_ROWSS = 86 * MiB + 512 * 1024, WS_ROWSS2 = 86 * MiB + 768 * 1024;
constexpr size_t WS_A = 88 * MiB;
constexpr size_t WS_Q = 217 * MiB;
constexpr size_t WS_K = WS_Q + (size_t)RPAD * 1024 * 2;
constexpr size_t WS_V = WS_K + (size_t)RPAD * 256 * 2;
constexpr size_t WS_U = WS_V + (size_t)RPAD * 256 * 2;
constexpr size_t WS_HB = WS_Q;
constexpr size_t WS_ACT = 379 * MiB;
static_assert(WS_U + (size_t)RPAD * 1024 * 2 <= WS_ACT && WS_HB + (size_t)RPAD * 2048 * 2 <= WS_ACT, "ws map");
static_assert(WS_ACT + (size_t)RPAD * 8192 * 2 <= 1024 * MiB, "ws map end");

namespace pg8 {
#define PG8_LAS __attribute__((address_space(3)))
typedef unsigned short bf16_t;
typedef short bf16x8 __attribute__((ext_vector_type(8)));
typedef float f32x4 __attribute__((ext_vector_type(4)));
typedef unsigned u32x4 __attribute__((ext_vector_type(4)));
constexpr int BM = 256, BK = 64, HALF = 128, HTB = HALF * BK * 2  , STAGE_BYTES = 8 * HTB, NXCD = 8, WGM = 8;

__host__ __device__ __forceinline__ int lds_byte(int r, int c) { const int st = (r >> 4) * 2 + (c >> 5), rr = r & 15, cc = c & 31, ob = rr * 64 + cc * 2; return st * 1024 + (ob ^ (((ob >> 9) & 1) << 5)); }
__host__ __device__ __forceinline__ void stage_rc(int b, int& R, int& C) { const int st = b / 1024, sb = b % 1024, swz = sb ^ (((sb >> 9) & 1) << 5); R = (st >> 1) * 16 + swz / 64; C = (st & 1) * 32 + (swz % 64) / 2; }
__host__ __device__ __forceinline__ int perm32(int rho) { const int n = rho >> 4, i = rho & 15; return 8 * (i >> 2) + 4 * n + (i & 3); }

struct Unit { int pm, pn; };
struct Gemm { const bf16_t* A; const bf16_t* Bt; int M, N, K; };

struct StaticOrder {
    int nM, nN, nwg, G, c;
    __host__ __device__ void init(int M, int N, int G_, int c_) { nM = M / BM; nN = N / BM; nwg = nM * nN; G = G_; c = c_; }
    __host__ __device__ bool next(int i, Unit& u) const {
        const long L = (long)i * G + c; if (L >= nwg) return false;
        int wgid = (int)L; { const int q = nwg / NXCD, r = nwg % NXCD, xcd = wgid % NXCD, off = wgid / NXCD; wgid = (xcd < r ? xcd * (q + 1) : r * (q + 1) + (xcd - r) * q) + off; }
        const int nig = WGM * nN, gid = wgid / nig, fm = gid * WGM, gsz = (nM - fm) < WGM ? (nM - fm) : WGM;
        u.pm = fm + ((wgid % nig) % gsz); u.pn = (wgid % nig) / gsz; return true;
    }
    __device__ __forceinline__ void a_ready(const Unit&) const {}
    __device__ __forceinline__ void done(const Unit&) const {}
};

typedef float f32x2_t __attribute__((ext_vector_type(2)));
typedef __bf16 bf16x2_t __attribute__((ext_vector_type(2)));
__device__ __forceinline__ unsigned pk2(float lo, float hi) { f32x2_t v = {lo, hi}; bf16x2_t b = __builtin_convertvector(v, bf16x2_t); return __builtin_bit_cast(unsigned, b); }
__device__ __forceinline__ u32x4 pk8(const f32x4& a, const f32x4& b) { u32x4 w; w.x = pk2(a[0], a[1]); w.y = pk2(a[2], a[3]); w.z = pk2(b[0], b[1]); w.w = pk2(b[2], b[3]); return w; }
__device__ __forceinline__ float sumsq8(const f32x4& a, const f32x4& b) { return ((a[0] * a[0] + a[1] * a[1]) + (a[2] * a[2] + a[3] * a[3])) + ((b[0] * b[0] + b[1] * b[1]) + (b[2] * b[2] + b[3] * b[3])); }

struct EpiIn {
    static constexpr bool PERM = true, AFTER_DRAIN = false;
    bf16_t *Q, *Kb, *Vp, *U; const float* bias; const float* rope; float* out;
    __device__ __forceinline__ void operator()(const f32x4 (&acc)[2][2][4][2], const Unit& u, int wr, int wc, int fr, int fq) const {
        const int pn = u.pn, colw = wc * 32 + 8 * fq;
        f32x4 bv[2][2];
#pragma unroll
        for (int bj = 0; bj < 2; ++bj)
#pragma unroll
            for (int n = 0; n < 2; ++n) bv[bj][n] = *(const f32x4*)(bias + pn * 256 + bj * HALF + colw + 4 * n);
        const bool dorope = (pn < 5) && ((wc & 1) == 0);
#pragma unroll
        for (int ai = 0; ai < 2; ++ai)
#pragma unroll
            for (int m = 0; m < 4; ++m) {
                const int row = u.pm * BM + ai * HALF + wr * 64 + m * 16 + fr;
                const bool isP = row < MP, isS = (!isP) && row < MR;
                const int t = row & (SEQ - 1), b = row >> 11;
                if (pn >= 6) {
                    const int c = (pn - 6) * 128 + colw;
                    f32x4 o[2];
#pragma unroll
                    for (int n = 0; n < 2; ++n) {
                        const f32x4 val = acc[ai][0][m][n] + bv[0][n], gate = acc[ai][1][m][n] + bv[1][n];
#pragma unroll
                        for (int e = 0; e < 4; ++e) o[n][e] = val[e] * __builtin_amdgcn_rcpf(1.0f + __expf(-gate[e]));
                    }
                    *(u32x4*)(U + (size_t)row * CCH + c) = pk8(o[0], o[1]);
                    float* dst = nullptr;
                    if (isP && t >= SEQ - 30) dst = out + O_PC + ((size_t)(b * 30 + t - (SEQ - 30))) * CCH + c;
                    if (isS) dst = out + O_SC + ((size_t)((row - MP) * 30 + 29)) * CCH + c;
                    if (dst) { *(f32x4*)dst = o[0]; *(f32x4*)(dst + 4) = o[1]; }
                } else {
                    f32x4 c0, c1, s0, s1;
                    if (dorope) { const float* rp = rope + (size_t)(isP ? t : SEQ) * 16; c0 = *(const f32x4*)rp; c1 = *(const f32x4*)(rp + 4); s0 = *(const f32x4*)(rp + 8); s1 = *(const f32x4*)(rp + 12);
                        if (fq == 0) { s0 = -s0; s1 = -s1; } }
#pragma unroll
                    for (int bj = 0; bj < 2; ++bj) {
                        f32x4 v0 = acc[ai][bj][m][0] + bv[bj][0], v1 = acc[ai][bj][m][1] + bv[bj][1];
                        if (dorope) {
                            f32x4 p0, p1;
#pragma unroll
                            for (int e = 0; e < 4; ++e) { p0[e] = __shfl_xor(v0[e], 16); p1[e] = __shfl_xor(v1[e], 16); }
                            if (fq < 2) { v0 = v0 * c0 + p0 * s0; v1 = v1 * c1 + p1 * s1; }
                        }
                        const int col = bj * HALF + colw;
                        const u32x4 w = pk8(v0, v1);
                        if (pn < 4) { *(u32x4*)(Q + (size_t)row * QD + pn * 256 + col) = w; }
                        else {
                            if (pn == 4) { *(u32x4*)(Kb + (size_t)row * KVD + col) = w; }
                            else if (isP) {
                                const int kvh = col >> 6, d = col & 63, kb = t >> 5, kap = t & 31;
                                const int i = kap & 3, hh = (kap >> 2) & 1, j = kap >> 3, s = j >> 1, e0 = 4 * (j & 1) + i;
                                bf16_t* vp = Vp + (size_t)(b * 4 + kvh) * (SEQ * 64) + (size_t)((((kb * 2 + (d >> 5)) * 2 + s) * 2 + hh) * 256) + (d & 31) * 8 + e0;
                                vp[0] = (bf16_t)(w.x & 0xffffu); vp[8] = (bf16_t)(w.x >> 16); vp[16] = (bf16_t)(w.y & 0xffffu); vp[24] = (bf16_t)(w.y >> 16);
                                vp[32] = (bf16_t)(w.z & 0xffffu); vp[40] = (bf16_t)(w.z >> 16); vp[48] = (bf16_t)(w.w & 0xffffu); vp[56] = (bf16_t)(w.w >> 16);
                            }
                            float* dst = nullptr;
                            if (isP && t >= SEQ - 128) dst = out + (pn == 4 ? O_PK : O_PV) + ((size_t)(b * 128 + t - (SEQ - 128))) * KVD + col;
                            if (isS) dst = out + (pn == 4 ? O_SK : O_SV) + ((size_t)((row - MP) * 128 + 127)) * KVD + col;
                            if (dst) { *(f32x4*)dst = v0; *(f32x4*)(dst + 4) = v1; }
                        }
                    }
                }
            }
    }
};

struct EpiOut {
    static constexpr bool PERM = true, AFTER_DRAIN = false;
    const float *xp, *xs, *bias; float* out; bf16_t* HB; float* rowss;
    __device__ __forceinline__ void operator()(const f32x4 (&acc)[2][2][4][2], const Unit& u, int wr, int wc, int fr, int fq) const {
        const int colb = u.pn * BM + wc * 32 + 8 * fq;
        f32x4 bv[2][2];
#pragma unroll
        for (int bj = 0; bj < 2; ++bj)
#pragma unroll
            for (int n = 0; n < 2; ++n) bv[bj][n] = *(const f32x4*)(bias + colb + bj * HALF + 4 * n);
#pragma unroll
        for (int ai = 0; ai < 2; ++ai)
#pragma unroll
            for (int m = 0; m < 4; ++m) {
                const int row = u.pm * BM + ai * HALF + wr * 64 + m * 16 + fr;
                const float* xr = row < MP ? xp + (size_t)row * DM : (row < MR ? xs + (size_t)(row - MP) * DM : nullptr);
                float ss = 0.f;
#pragma unroll
                for (int bj = 0; bj < 2; ++bj) {
                    const int col = colb + bj * HALF;
                    f32x4 v0 = acc[ai][bj][m][0] + bv[bj][0], v1 = acc[ai][bj][m][1] + bv[bj][1];
                    if (xr) { v0 += *(const f32x4*)(xr + col); v1 += *(const f32x4*)(xr + col + 4);
                        float* o = out + (size_t)row * DM + col; *(f32x4*)o = v0; *(f32x4*)(o + 4) = v1; }
                    *(u32x4*)(HB + (size_t)row * DM + col) = pk8(v0, v1);
                    ss += sumsq8(v0, v1);
                }
                ss += __shfl_xor(ss, 16); ss += __shfl_xor(ss, 32);
                if (fq == 0) unsafeAtomicAdd(rowss + row, ss);
            }
    }
};

struct EpiUp {
    static constexpr bool PERM = true, AFTER_DRAIN = false;
    bf16_t* ACT; const float* rowss;
    __device__ __forceinline__ void operator()(const f32x4 (&acc)[2][2][4][2], const Unit& u, int wr, int wc, int fr, int fq) const {
        const int colb = u.pn * BM + wc * 32 + 8 * fq;
#pragma unroll
        for (int ai = 0; ai < 2; ++ai)
#pragma unroll
            for (int m = 0; m < 4; ++m) {
                const int row = u.pm * BM + ai * HALF + wr * 64 + m * 16 + fr;
                const float rr = 1.0f / (rowss[row] * (1.0f / DM) + EPS);
#pragma unroll
                for (int bj = 0; bj < 2; ++bj) {
                    f32x4 v0 = acc[ai][bj][m][0], v1 = acc[ai][bj][m][1];
#pragma unroll
                    for (int e = 0; e < 4; ++e) { const float a = fmaxf(v0[e], 0.f), c = fmaxf(v1[e], 0.f); v0[e] = a * a * rr; v1[e] = c * c * rr; }
                    *(u32x4*)(ACT + (size_t)row * DFF + colb + bj * HALF) = pk8(v0, v1);
                }
            }
    }
};

struct EpiDown {
    static constexpr bool PERM = true, AFTER_DRAIN = false;
    float* out; float* rowss;
    __device__ __forceinline__ void operator()(const f32x4 (&acc)[2][2][4][2], const Unit& u, int wr, int wc, int fr, int fq) const {
        const int colb = u.pn * BM + wc * 32 + 8 * fq;
#pragma unroll
        for (int ai = 0; ai < 2; ++ai)
#pragma unroll
            for (int m = 0; m < 4; ++m) {
                const int row = u.pm * BM + ai * HALF + wr * 64 + m * 16 + fr;
                if (row < MR) {
                    float ss = 0.f;
#pragma unroll
                    for (int bj = 0; bj < 2; ++bj) {
                        float* o = out + (size_t)row * DM + colb + bj * HALF;
                        const f32x4 v0 = acc[ai][bj][m][0] + *(const f32x4*)o, v1 = acc[ai][bj][m][1] + *(const f32x4*)(o + 4);
                        *(f32x4*)o = v0; *(f32x4*)(o + 4) = v1;
                        ss += sumsq8(v0, v1);
                    }
                    ss += __shfl_xor(ss, 16); ss += __shfl_xor(ss, 32);
                    if (fq == 0) unsafeAtomicAdd(rowss + row, ss);
                }
            }
    }
};

template <class Epi, class Sched, bool ALIGN_EPI = false, bool SP2 = false>
__device__ __forceinline__ void gemm_phase(PG8_LAS unsigned char* lds, const Gemm g, const Sched& S, const Epi& E) {
    const int tid = threadIdx.x, wid = __builtin_amdgcn_readfirstlane(tid >> 6), lane = tid & 63, wr = wid >> 2, wc = wid & 3, fr = lane & 15, fq = lane >> 4;
    const int K = g.K, nt = K / BK;
    unsigned voffA[2], voffB[2];
#pragma unroll
    for (int i = 0; i < 2; ++i) { int R, C; stage_rc(tid * 16 + i * 8192, R, C); const int Rb = Epi::PERM ? ((R & ~31) + perm32(R & 31)) : R;
        voffA[i] = (unsigned)(R * K + C) * 2u; voffB[i] = (unsigned)(Rb * K + C) * 2u; }
    const size_t kstep = (size_t)(BK * 2);
    const size_t hstep = (size_t)HALF * K * 2;
    const size_t tstep = 2 * hstep;
    const unsigned ldsw = (unsigned)wid * 1024u;
    const int aoff = lds_byte(wr * 64 + fr, fq * 8), boff = lds_byte(wc * 32 + fr, fq * 8);
#define PG8_SA(b, h) (((b) * 2 + (h)) * HTB)
#define PG8_SB(b, h) ((4 + (b) * 2 + (h)) * HTB)
#define PG8_STAGE(bufoff, gbase, voff) do { _Pragma("unroll") for (int _i = 0; _i < 2; ++_i) \
        __builtin_amdgcn_global_load_lds((const unsigned*)((const char*)(gbase) + (voff)[_i]), (PG8_LAS unsigned*)(lds + (bufoff) + ldsw + _i * 8192), 16, 0, 0); } while (0)
#define PG8_LDA(dst, b, h) do { _Pragma("unroll") for (int m = 0; m < 4; ++m) _Pragma("unroll") for (int k = 0; k < 2; ++k) dst[m][k] = *(const PG8_LAS bf16x8*)(lds + PG8_SA(b, h) + aoff + m * 2048 + k * 1024); } while (0)
#define PG8_LDB(dst, b, h) do { _Pragma("unroll") for (int n = 0; n < 2; ++n) _Pragma("unroll") for (int k = 0; k < 2; ++k) dst[n][k] = *(const PG8_LAS bf16x8*)(lds + PG8_SB(b, h) + boff + n * 2048 + k * 1024); } while (0)
#define PG8_MMA(ai, bj, At, Bt) do { __builtin_amdgcn_s_setprio(1); _Pragma("unroll") for (int m = 0; m < 4; ++m) _Pragma("unroll") for (int n = 0; n < 2; ++n) _Pragma("unroll") for (int k = 0; k < 2; ++k) \
        acc[ai][bj][m][n] = __builtin_amdgcn_mfma_f32_16x16x32_bf16(Bt[n][k], At[m][k], acc[ai][bj][m][n], 0, 0, 0); __builtin_amdgcn_s_setprio(0); } while (0)
#define PG8_WAIT_V(n) asm volatile("s_waitcnt vmcnt(" #n ")" ::: "memory")
#define PG8_WAIT_L(n) asm volatile("s_waitcnt lgkmcnt(" #n ")" ::: "memory")
#define PG8_BAR __builtin_amdgcn_s_barrier()
#define PG8_SCHED __builtin_amdgcn_sched_barrier(0)
    Unit cur, nxt; int ui = 0;
    if (!S.next(0, cur)) return;
    f32x4 acc[2][2][4][2];
#pragma unroll
    for (int a = 0; a < 2; ++a)
#pragma unroll
        for (int b = 0; b < 2; ++b)
#pragma unroll
            for (int m = 0; m < 4; ++m)
#pragma unroll
                for (int n = 0; n < 2; ++n) acc[a][b][m][n] = (f32x4){0.f, 0.f, 0.f, 0.f};
    bf16x8 At[4][2], B0[2][2], B1[2][2];
    const char* cA = (const char*)g.A + (size_t)cur.pm * tstep; const char* cB = (const char*)g.Bt + (size_t)cur.pn * tstep;
    S.a_ready(cur);
    if constexpr (SP2) {
        PG8_STAGE(PG8_SB(0, 0), cB, voffB); PG8_STAGE(PG8_SB(0, 1), cB + hstep, voffB); PG8_STAGE(PG8_SA(0, 0), cA, voffA); PG8_STAGE(PG8_SA(0, 1), cA + hstep, voffA);
        if (wr == 1) PG8_BAR;
        PG8_WAIT_V(2); PG8_BAR;
        PG8_STAGE(PG8_SB(1, 0), cB + kstep, voffB); PG8_STAGE(PG8_SA(1, 0), cA + kstep, voffA); PG8_STAGE(PG8_SB(1, 1), cB + hstep + kstep, voffB);
        PG8_WAIT_V(6); PG8_BAR;
    } else {
        PG8_STAGE(PG8_SB(0, 0), cB, voffB); PG8_STAGE(PG8_SA(0, 0), cA, voffA); PG8_STAGE(PG8_SB(0, 1), cB + hstep, voffB); PG8_STAGE(PG8_SA(0, 1), cA + hstep, voffA);
        if (wr == 1) PG8_BAR;
        PG8_WAIT_V(4); PG8_BAR;
        PG8_STAGE(PG8_SB(1, 0), cB + kstep, voffB); PG8_STAGE(PG8_SA(1, 0), cA + kstep, voffA); PG8_STAGE(PG8_SB(1, 1), cB + hstep + kstep, voffB);
        PG8_WAIT_V(6); PG8_BAR;
    }
    for (;;) {
        const bool has_next = S.next(ui + 1, nxt);
        const char* nA = has_next ? (const char*)g.A + (size_t)nxt.pm * tstep : cA; const char* nB = has_next ? (const char*)g.Bt + (size_t)nxt.pn * tstep : cB;
        for (int t = 0; t < nt; t += 2) {
            const bool last = (t == nt - 2);
            const char* a1 = cA + (size_t)(t + 1) * kstep;
            const char* a2 = last ? nA : cA + (size_t)(t + 2) * kstep; const char* b2 = last ? nB : cB + (size_t)(t + 2) * kstep;
            const char* a3 = a2 + kstep; const char* b3 = b2 + kstep;
            if (last && has_next) S.a_ready(nxt);
            if constexpr (SP2) {
            PG8_LDB(B0, 0, 0); PG8_LDB(B1, 0, 1); PG8_SCHED; PG8_LDA(At, 0, 0); PG8_STAGE(PG8_SA(1, 1), a1 + hstep, voffA);
            PG8_WAIT_V(8); PG8_WAIT_L(0); PG8_BAR; PG8_MMA(0, 0, At, B0); PG8_MMA(0, 1, At, B1); PG8_BAR; PG8_SCHED;
            PG8_LDA(At, 0, 1); PG8_STAGE(PG8_SB(0, 0), b2, voffB); PG8_STAGE(PG8_SB(0, 1), b2 + hstep, voffB); PG8_STAGE(PG8_SA(0, 0), a2, voffA);
            PG8_WAIT_V(8); PG8_WAIT_L(0); PG8_BAR; PG8_MMA(1, 0, At, B0); PG8_MMA(1, 1, At, B1); PG8_BAR; PG8_SCHED;
            PG8_LDB(B0, 1, 0); PG8_LDB(B1, 1, 1); PG8_SCHED; PG8_LDA(At, 1, 0); PG8_STAGE(PG8_SA(0, 1), a2 + hstep, voffA);
            PG8_WAIT_V(8); PG8_WAIT_L(0); PG8_BAR; PG8_MMA(0, 0, At, B0); PG8_MMA(0, 1, At, B1); PG8_BAR; PG8_SCHED;
            PG8_LDA(At, 1, 1); PG8_STAGE(PG8_SB(1, 0), b3, voffB); PG8_STAGE(PG8_SB(1, 1), b3 + hstep, voffB); PG8_STAGE(PG8_SA(1, 0), a3, voffA);
            PG8_WAIT_V(8); PG8_WAIT_L(0); PG8_BAR; PG8_MMA(1, 0, At, B0); PG8_MMA(1, 1, At, B1); PG8_BAR; PG8_SCHED;
            } else {
            PG8_LDB(B0, 0, 0); PG8_SCHED; PG8_LDA(At, 0, 0); PG8_STAGE(PG8_SA(1, 1), a1 + hstep, voffA);
            PG8_WAIT_L(8); PG8_BAR; PG8_WAIT_L(0); PG8_MMA(0, 0, At, B0); PG8_BAR; PG8_SCHED;
            PG8_LDB(B1, 0, 1); PG8_STAGE(PG8_SB(0, 0), b2, voffB);
            PG8_BAR; PG8_WAIT_L(0); PG8_MMA(0, 1, At, B1); PG8_BAR;
            PG8_LDA(At, 0, 1); PG8_STAGE(PG8_SA(0, 0), a2, voffA);
            PG8_BAR; PG8_WAIT_L(0); PG8_MMA(1, 0, At, B0); PG8_BAR; PG8_SCHED;
            PG8_STAGE(PG8_SB(0, 1), b2 + hstep, voffB);
            PG8_WAIT_V(6); PG8_BAR; PG8_MMA(1, 1, At, B1); PG8_BAR;
            PG8_LDB(B0, 1, 0); PG8_SCHED; PG8_LDA(At, 1, 0); PG8_STAGE(PG8_SA(0, 1), a2 + hstep, voffA);
            PG8_WAIT_L(8); PG8_BAR; PG8_WAIT_L(0); PG8_MMA(0, 0, At, B0); PG8_BAR; PG8_SCHED;
            PG8_LDB(B1, 1, 1); PG8_STAGE(PG8_SB(1, 0), b3, voffB);
            PG8_BAR; PG8_WAIT_L(0); PG8_MMA(0, 1, At, B1); PG8_BAR;
            PG8_LDA(At, 1, 1); PG8_STAGE(PG8_SA(1, 0), a3, voffA);
            PG8_BAR; PG8_WAIT_L(0); PG8_MMA(1, 0, At, B0); PG8_BAR; PG8_SCHED;
            PG8_STAGE(PG8_SB(1, 1), b3 + hstep, voffB);
            PG8_WAIT_V(6); PG8_BAR; PG8_MMA(1, 1, At, B1); PG8_BAR;
            }
        }
        if constexpr (ALIGN_EPI) { if (wr == 0) PG8_BAR; }
        if constexpr (!Epi::AFTER_DRAIN) { E(acc, cur, wr, wc, fr, fq); S.done(cur); }
        if (!has_next) break;
#pragma unroll
        for (int a = 0; a < 2; ++a)
#pragma unroll
            for (int b = 0; b < 2; ++b)
#pragma unroll
                for (int m = 0; m < 4; ++m)
#pragma unroll
                    for (int n = 0; n < 2; ++n) acc[a][b][m][n] = (f32x4){0.f, 0.f, 0.f, 0.f};
        cur = nxt; cA = nA; cB = nB; ++ui;
        if constexpr (ALIGN_EPI) { if (wr == 1) PG8_BAR; }
    }
    PG8_WAIT_V(0);
    if constexpr (!ALIGN_EPI) { if (wr == 0) PG8_BAR; }
    PG8_BAR;
    if constexpr (Epi::AFTER_DRAIN) { E.fused(acc, cur, wr, wc, fr, fq, lds, wid, lane); S.done(cur); }
#undef PG8_SA
#undef PG8_SB
#undef PG8_STAGE
#undef PG8_LDA
#undef PG8_LDB
#undef PG8_MMA
#undef PG8_WAIT_V
#undef PG8_WAIT_L
#undef PG8_BAR
#undef PG8_SCHED
}
}

constexpr int RING_OFF = 0, RING_BYTES = 131072;
constexpr int LDS_BYTES = 147456;
constexpr int NWAVES = 8;
#define LAS __attribute__((address_space(3)))
typedef unsigned short bf16;
typedef unsigned v4u __attribute__((ext_vector_type(4)));
typedef unsigned v2u __attribute__((ext_vector_type(2)));
typedef float f32x4 __attribute__((ext_vector_type(4)));
typedef float f32x16 __attribute__((ext_vector_type(16)));
typedef short bf16x8 __attribute__((ext_vector_type(8)));
#define LDS_WAIT() asm volatile("s_waitcnt lgkmcnt(0)" ::: "memory")
using pg8::pk2;

__device__ __forceinline__ float wave_sum(float v) {
#pragma unroll
    for (int o = 1; o < 64; o <<= 1) v += __shfl_xor(v, o);
    return v;
}
__device__ __forceinline__ float wave_max(float v) {
#pragma unroll
    for (int o = 1; o < 64; o <<= 1) v = fmaxf(v, __shfl_xor(v, o));
    return v;
}
__device__ __forceinline__ float bf_lo(unsigned x) { return __uint_as_float(x << 16); }
__device__ __forceinline__ float bf_hi(unsigned x) { return __uint_as_float(x & 0xffff0000u); }

struct Frame {
    LAS unsigned char* lds;
    int tid, lane, wave, G;
    const float* in[19]; float* out; unsigned char* ws;
};

__device__ __forceinline__ void p0_transpose_item(const float* W, int K, int N, bf16* WT, int k0, int n0, int drow0, const float* kscale, LAS float* scr, int lane) {
#pragma unroll 8
    for (int i = 0; i < 32; ++i) { const int kk = 2 * i + (lane >> 5); float v = W[(size_t)(k0 + kk) * N + n0 + (lane & 31)]; if (kscale) v *= kscale[k0 + kk]; scr[kk * 33 + (lane & 31)] = v; }
    LDS_WAIT(); asm volatile("" ::: "memory");
    const int c = lane & 7;
#pragma unroll
    for (int j = 0; j < 4; ++j) { const int n = (lane >> 3) + 8 * j; const LAS float* s = scr + (8 * c) * 33 + n;
        v4u o; o.x = pk2(s[0 * 33], s[1 * 33]); o.y = pk2(s[2 * 33], s[3 * 33]); o.z = pk2(s[4 * 33], s[5 * 33]); o.w = pk2(s[6 * 33], s[7 * 33]);
        *(v4u*)(WT + (size_t)(drow0 + n) * K + k0 + 8 * c) = o; }
    LDS_WAIT(); asm volatile("" ::: "memory");
}
__device__ __forceinline__ int inproj_row(int n) {
    if (n < 1536) return n;
    if (n < 2560) { const int c = n - 1536; return 1536 + (c >> 7) * 256 + (c & 127); }
    const int c = n - 2560; return 1536 + (c >> 7) * 256 + 128 + (c & 127);
}
__device__ __forceinline__ void sincos_acc(float ang, float& c, float& s) {
    const double x = (double)ang;
    const double n = rint(x * 0.63661977236758134308);
    double r = fma(-n, 1.57079632679489655800, x); r = fma(-n, 6.12323399573676603587e-17, r);
    const int q = ((int)n) & 3;
    const double r2 = r * r;
    const double sp = r * (1.0 + r2 * (-1.0 / 6 + r2 * (1.0 / 120 + r2 * (-1.0 / 5040 + r2 * (1.0 / 362880 + r2 * (-1.0 / 39916800 + r2 * (1.0 / 6227020800.0)))))));
    const double cp = 1.0 + r2 * (-0.5 + r2 * (1.0 / 24 + r2 * (-1.0 / 720 + r2 * (1.0 / 40320 + r2 * (-1.0 / 3628800 + r2 * (1.0 / 479001600 + r2 * (-1.0 / 87178291200.0)))))));
    const double ss = (q == 0) ? sp : (q == 1) ? cp : (q == 2) ? -sp : -cp;
    const double cc = (q == 0) ? cp : (q == 1) ? -sp : (q == 2) ? -cp : sp;
    c = (float)cc; s = (float)ss;
}
__device__ __forceinline__ void p0_prologue(Frame& F) {
    LAS float* scr = (LAS float*)(F.lds + RING_OFF + F.wave * 16384);
    const int gw = blockIdx.x * NWAVES + F.wave, NGW = F.G * NWAVES;
    const int gt = blockIdx.x * (NWAVES * 64) + F.tid, NGT = F.G * NWAVES * 64;
    bf16* Win = (bf16*)(F.ws + WS_WIN); bf16* Wout = (bf16*)(F.ws + WS_WOUT); bf16* Wup = (bf16*)(F.ws + WS_WUP); bf16* Wdn = (bf16*)(F.ws + WS_WDN);
    { float* rope = (float*)(F.ws + WS_ROPE);
      for (int e = gt; e < (SEQ + 1) * 8; e += NGT) { const int p = e >> 3, i = e & 7; const float pos = (p < SEQ) ? (float)p : 16384.0f;
          const float invf[8] = {1.0f, 0.19392274474868576f, 0.03760603093086393f, 0.007292664737217109f, 0.001414213562373095f, 0.0002742481756762073f, 5.318295896944988e-05f, 1.031338537721246e-05f};
          float fsel = invf[0];
#pragma unroll
          for (int k = 1; k < 8; ++k) fsel = (i == k) ? invf[k] : fsel;
          const float ang = pos * fsel; float c, s; sincos_acc(ang, c, s); rope[p * 16 + i] = c; rope[p * 16 + 8 + i] = s; }
      float* bperm = (float*)(F.ws + WS_BPERM); const float* b_in = F.in[7];
      for (int n = gt; n < IN_DIM; n += NGT) bperm[inproj_row(n)] = b_in[n];
      float* rs = (float*)(F.ws + WS_ROWSS); float* rs2 = (float*)(F.ws + WS_ROWSS2);
      for (int r = gt; r < RPAD; r += NGT) { rs[r] = 0.f; rs2[r] = 0.f; } }
    constexpr int I_IN = (DM / 64) * (IN_DIM / 32), I_OUT = (DM / 64) * (DM / 32), I_UP = (DM / 64) * (DFF / 32), I_DN = (DFF / 64) * (DM / 32);
    constexpr int NITEMS = I_IN + I_OUT + I_UP + I_DN;
    for (int it = gw; it < NITEMS; it += NGW) {
        int r = it;
        if (r < I_IN) { const int nblk = IN_DIM / 32, kb = r / nblk, nb = r % nblk; p0_transpose_item(F.in[6], DM, IN_DIM, Win, 64 * kb, 32 * nb, inproj_row(32 * nb), nullptr, scr, F.lane); continue; } r -= I_IN;
        if (r < I_OUT) { const int nblk = DM / 32, kb = r / nblk, nb = r % nblk; p0_transpose_item(F.in[13], DM, DM, Wout, 64 * kb, 32 * nb, 32 * nb, nullptr, scr, F.lane); continue; } r -= I_OUT;
        if (r < I_UP) { const int nblk = DFF / 32, kb = r / nblk, nb = r % nblk; p0_transpose_item(F.in[16], DM, DFF, Wup, 64 * kb, 32 * nb, 32 * nb, F.in[15], scr, F.lane); continue; } r -= I_UP;
        { const int nblk = DM / 32, kb = r / nblk, nb = r % nblk; p0_transpose_item(F.in[17], DFF, DM, Wdn, 64 * kb, 32 * nb, 32 * nb, nullptr, scr, F.lane); }
    }
    bf16* XN = (bf16*)(F.ws + WS_A); const float* g1 = F.in[5];
    for (int m = gw; m < RPAD; m += NGW) {
        v2u* o8 = (v2u*)(XN + (size_t)m * DM) + F.lane;
        if (m >= MR) {
#pragma unroll
            for (int j = 0; j < 8; ++j) o8[64 * j] = (v2u){0u, 0u};
            continue; }
        const float* xrow = m < MP ? F.in[0] + (size_t)m * DM : F.in[1] + (size_t)(m - MP) * DM;
        const f32x4* xr = (const f32x4*)xrow + F.lane;
        f32x4 v[8]; float s = 0.f;
#pragma unroll
        for (int j = 0; j < 8; ++j) { v[j] = xr[64 * j]; s += (v[j].x * v[j].x + v[j].y * v[j].y) + (v[j].z * v[j].z + v[j].w * v[j].w); }
        const float rstd = 1.0f / sqrtf(wave_sum(s) * (1.0f / DM) + EPS);
#pragma unroll
        for (int j = 0; j < 8; ++j) { const f32x4 g = *((const f32x4*)g1 + F.lane + 64 * j);
            o8[64 * j] = (v2u){pk2(v[j].x * rstd * g.x, v[j].y * rstd * g.y), pk2(v[j].z * rstd * g.z, v[j].w * rstd * g.w)}; }
    }
}

#define MFMA32(a, b, c) __builtin_amdgcn_mfma_f32_32x32x16_bf16((a), (b), (c), 0, 0, 0)
__device__ __forceinline__ int crow(int r, int hi) { return (r & 3) + 8 * (r >> 2) + 4 * hi; }

__device__ __forceinline__ void attn_wave_unit(int b, int h, int qb, const bf16* Q, const bf16* Kb, const bf16* Vp, bf16* mix, float sink2, int lane) {
    const int r32 = lane & 31, hi = lane >> 5, kvh = h >> 2;
    const size_t row0 = (size_t)b * SEQ + qb * 32;
    bf16x8 qf[4];
#pragma unroll
    for (int d0 = 0; d0 < 4; ++d0) qf[d0] = *(const bf16x8*)(Q + (row0 + r32) * QD + h * 64 + d0 * 16 + hi * 8);
    f32x16 S[5];
#pragma unroll
    for (int jb = 0; jb < 5; ++jb) {
        const int kblk = qb - 4 + jb;
        f32x16 a;
#pragma unroll
        for (int r = 0; r < 16; ++r) a[r] = 0.f;
        if (kblk >= 0) {
            const bf16* kp = Kb + ((size_t)b * SEQ + kblk * 32 + r32) * KVD + kvh * 64 + hi * 8;
#pragma unroll
            for (int d0 = 0; d0 < 4; ++d0) a = MFMA32(*(const bf16x8*)(kp + d0 * 16), qf[d0], a);
        }
        S[jb] = a;
    }
    float mx = sink2;
#pragma unroll
    for (int jb = 0; jb < 5; ++jb) {
        const int kblk = qb - 4 + jb;
#pragma unroll
        for (int r = 0; r < 16; ++r) {
            float x = S[jb][r] * C2;
            bool ok = kblk >= 0;
            if (jb == 0) ok = ok && (crow(r, hi) > r32);
            if (jb == 4) ok = ok && (crow(r, hi) <= r32);
            x = ok ? x : -INFINITY;
            S[jb][r] = x; mx = fmaxf(mx, x);
        }
    }
    mx = fmaxf(mx, __shfl_xor(mx, 32));
    float l = 0.f;
#pragma unroll
    for (int jb = 0; jb < 5; ++jb)
#pragma unroll
        for (int r = 0; r < 16; ++r) { const float p = __builtin_amdgcn_exp2f(S[jb][r] - mx); S[jb][r] = p; l += p; }
    l += __shfl_xor(l, 32);
    l += __builtin_amdgcn_exp2f(sink2 - mx);
    f32x16 o[2];
#pragma unroll
    for (int r = 0; r < 16; ++r) { o[0][r] = 0.f; o[1][r] = 0.f; }
    const bf16* vplane = Vp + (size_t)(b * 4 + kvh) * (SEQ * 64) + lane * 8;
#pragma unroll
    for (int jb = 0; jb < 5; ++jb) {
        const int kblk = qb - 4 + jb;
        if (kblk >= 0) {
#pragma unroll
            for (int s = 0; s < 2; ++s) {
                v4u pw; pw.x = pk2(S[jb][8 * s + 0], S[jb][8 * s + 1]); pw.y = pk2(S[jb][8 * s + 2], S[jb][8 * s + 3]); pw.z = pk2(S[jb][8 * s + 4], S[jb][8 * s + 5]); pw.w = pk2(S[jb][8 * s + 6], S[jb][8 * s + 7]);
                const bf16x8 pf = __builtin_bit_cast(bf16x8, pw);
#pragma unroll
                for (int db = 0; db < 2; ++db) {
                    const bf16x8 vf = *(const bf16x8*)(vplane + (size_t)((kblk * 2 + db) * 2 + s) * 512);
                    o[db] = MFMA32(vf, pf, o[db]);
                }
            }
        }
    }
    const float inv = 1.0f / l;
    bf16* orow = mix + (row0 + r32) * DM + h * 64 + 4 * hi;
#pragma unroll
    for (int db = 0; db < 2; ++db)
#pragma unroll
        for (int g4 = 0; g4 < 4; ++g4) {
            v2u w; w.x = pk2(o[db][4 * g4 + 0] * inv, o[db][4 * g4 + 1] * inv); w.y = pk2(o[db][4 * g4 + 2] * inv, o[db][4 * g4 + 3] * inv);
            *(v2u*)(orow + 32 * db + 8 * g4) = w;
        }
}

__device__ __forceinline__ void sample_attn_unit(int sb, int h, const Frame& F, const bf16* Q, bf16* mix, bool docopy) {
    const int lane = F.lane, kvh = h >> 2;
    const float* cache_k = F.in[2]; const float* cache_v = F.in[3];
    float* sk = F.out + O_SK; float* sv = F.out + O_SV;
    const float sink2 = F.in[8][h] * LOG2E;
    const bf16* qrow = Q + (size_t)(MP + sb) * QD + h * 64;
    float sc[2];
#pragma unroll
    for (int half = 0; half < 2; ++half) {
        const int j = lane + 64 * half;
        const float* kr = (j < 127) ? cache_k + ((size_t)(sb * 128 + j + 1) * 4 + kvh) * 64 : sk + ((size_t)(sb * 128 + 127) * 4 + kvh) * 64;
        float* kd = sk + ((size_t)(sb * 128 + j) * 4 + kvh) * 64;
        float dot = 0.f;
#pragma unroll
        for (int d4 = 0; d4 < 16; ++d4) {
            const f32x4 kv = *(const f32x4*)(kr + d4 * 4);
            const v2u qq = *(const v2u*)(qrow + d4 * 4);
            dot += kv.x * bf_lo(qq.x) + kv.y * bf_hi(qq.x) + kv.z * bf_lo(qq.y) + kv.w * bf_hi(qq.y);
            if (docopy && j < 127) *(f32x4*)(kd + d4 * 4) = kv;
        }
        sc[half] = dot * C2;
    }
    const float mx = fmaxf(sink2, wave_max(fmaxf(sc[0], sc[1])));
    const float p0 = __builtin_amdgcn_exp2f(sc[0] - mx), p1 = __builtin_amdgcn_exp2f(sc[1] - mx);
    const float l = wave_sum(p0 + p1) + __builtin_amdgcn_exp2f(sink2 - mx);
    float o = 0.f;
#pragma unroll 4
    for (int j = 0; j < 128; ++j) {
        const float pj = __shfl(j < 64 ? p0 : p1, j & 63);
        const float* vr = (j < 127) ? cache_v + ((size_t)(sb * 128 + j + 1) * 4 + kvh) * 64 : sv + ((size_t)(sb * 128 + 127) * 4 + kvh) * 64;
        const float v = vr[lane];
        o += pj * v;
        if (docopy && j < 127) (sv + ((size_t)(sb * 128 + j) * 4 + kvh) * 64)[lane] = v;
    }
    const float r = o / l;
    const float r2 = __shfl_down(r, 1);
    if ((lane & 1) == 0) *(unsigned*)(mix + (size_t)(MP + sb) * DM + h * 64 + lane) = pk2(r, r2);
}

__device__ __forceinline__ void sample_conv_unit(int sb, const Frame& F, bf16* mix) {
    const int lane = F.lane;
    const float* cc = F.in[4] + (size_t)sb * 30 * CCH; const float* cw = F.in[9];
    float* sc = F.out + O_SC + (size_t)sb * 30 * CCH;
    f32x4 y[4];
#pragma unroll
    for (int k = 0; k < 4; ++k) {
        const int c = lane * 4 + 256 * k;
        f32x4 a = *(const f32x4*)(F.in[10] + c);
#pragma unroll 2
        for (int j = 0; j < 30; ++j) { const f32x4 uv = *(const f32x4*)(cc + (size_t)j * CCH + c); a += *(const f32x4*)(cw + (size_t)j * CCH + c) * uv; if (j >= 1) *(f32x4*)(sc + (size_t)(j - 1) * CCH + c) = uv; }
        const f32x4 un = *(const f32x4*)(sc + (size_t)29 * CCH + c);
        a += *(const f32x4*)(cw + (size_t)30 * CCH + c) * un;
        y[k] = a;
    }
    float s = 0.f;
#pragma unroll
    for (int k = 0; k < 4; ++k) s += (y[k].x + y[k].y) + (y[k].z + y[k].w);
    const float mu = wave_sum(s) * (1.0f / CCH);
    float q = 0.f;
#pragma unroll
    for (int k = 0; k < 4; ++k) { y[k] = y[k] - mu; q += (y[k].x * y[k].x + y[k].y * y[k].y) + (y[k].z * y[k].z + y[k].w * y[k].w); }
    const float rstd = 1.0f / sqrtf(wave_sum(q) * (1.0f / CCH) + EPS);
#pragma unroll
    for (int k = 0; k < 4; ++k) {
        const int c = lane * 4 + 256 * k;
        const f32x4 g = *(const f32x4*)(F.in[11] + c), bb = *(const f32x4*)(F.in[12] + c);
        f32x4 yn = y[k] * rstd * g + bb;
#pragma unroll
        for (int e = 0; e < 4; ++e) yn[e] = yn[e] * __builtin_amdgcn_rcpf(1.0f + __expf(-yn[e]));
        *(v2u*)(mix + (size_t)(MP + sb) * DM + QD + c) = (v2u){pk2(yn.x, yn.y), pk2(yn.z, yn.w)};
    }
}

__device__ __forceinline__ void conv_prompt_unit(int b, int t0, const Frame& F, const bf16* U, bf16* mix, const float (&w0)[CONVW], const float (&w1)[CONVW],
                                                  float cb0, float cb1, float lg0, float lg1, float lb0, float lb1) {
    const int c0 = 2 * F.tid;
    LAS float* red = (LAS float*)(F.lds + RING_OFF);
    const bf16* ub = U + (size_t)b * SEQ * CCH + c0;
    float win0[38], win1[38];
#pragma unroll
    for (int i = 0; i < 30; ++i) { const int t = t0 - 30 + i; const unsigned x = (t >= 0) ? *(const unsigned*)(ub + (size_t)t * CCH) : 0u; win0[i] = bf_lo(x); win1[i] = bf_hi(x); }
    for (int bt = 0; bt < 16; ++bt) {
        const int tb = t0 + bt * 8;
#pragma unroll
        for (int r = 0; r < 8; ++r) { const unsigned x = *(const unsigned*)(ub + (size_t)(tb + r) * CCH); win0[30 + r] = bf_lo(x); win1[30 + r] = bf_hi(x); }
        float y0[8], y1[8], st[16];
#pragma unroll
        for (int r = 0; r < 8; ++r) {
            float a0 = cb0, a1 = cb1;
#pragma unroll
            for (int j = 0; j < CONVW; ++j) { a0 += w0[j] * win0[r + j]; a1 += w1[j] * win1[r + j]; }
            y0[r] = a0; y1[r] = a1; st[2 * r] = a0 + a1; st[2 * r + 1] = a0 * a0 + a1 * a1;
        }
#pragma unroll
        for (int k = 0; k < 16; ++k) st[k] = wave_sum(st[k]);
        LAS float* rb = red + (bt & 1) * 128;
        if (F.lane == 0) {
#pragma unroll
            for (int k = 0; k < 16; ++k) rb[F.wave * 16 + k] = st[k];
        }
        __syncthreads();
#pragma unroll
        for (int k = 0; k < 16; ++k) { float s = 0.f;
#pragma unroll
            for (int w = 0; w < 8; ++w) s += rb[w * 16 + k];
            st[k] = s; }
#pragma unroll
        for (int r = 0; r < 8; ++r) {
            const float mu = st[2 * r] * (1.0f / CCH), var = fmaxf(st[2 * r + 1] * (1.0f / CCH) - mu * mu, 0.f), rstd = 1.0f / sqrtf(var + EPS);
            float a = (y0[r] - mu) * rstd * lg0 + lb0, c = (y1[r] - mu) * rstd * lg1 + lb1;
            a = a * __builtin_amdgcn_rcpf(1.0f + __expf(-a)); c = c * __builtin_amdgcn_rcpf(1.0f + __expf(-c));
            *(unsigned*)(mix + ((size_t)b * SEQ + tb + r) * DM + QD + c0) = pk2(a, c);
        }
#pragma unroll
        for (int i = 0; i < 30; ++i) { win0[i] = win0[i + 8]; win1[i] = win1[i + 8]; }
    }
    __syncthreads();
}

__device__ __forceinline__ void p2_mixers(Frame& F) {
    const bf16* Q = (const bf16*)(F.ws + WS_Q); const bf16* Kb = (const bf16*)(F.ws + WS_K); const bf16* Vp = (const bf16*)(F.ws + WS_V); const bf16* U = (const bf16*)(F.ws + WS_U);
    bf16* mix = (bf16*)(F.ws + WS_A);
    {
        const int c0 = 2 * F.tid;
        float w0[CONVW], w1[CONVW];
#pragma unroll
        for (int j = 0; j < CONVW; ++j) { const float2 wv = *(const float2*)(F.in[9] + (size_t)j * CCH + c0); w0[j] = wv.x; w1[j] = wv.y; }
        const float2 cb = *(const float2*)(F.in[10] + c0), lg = *(const float2*)(F.in[11] + c0), lb = *(const float2*)(F.in[12] + c0);
        for (int unit = blockIdx.x; unit < NBATCH * 16; unit += F.G) conv_prompt_unit(unit >> 4, (unit & 15) * 128, F, U, mix, w0, w1, cb.x, cb.y, lg.x, lg.y, lb.x, lb.y);
    }
    const int gw = blockIdx.x * NWAVES + F.wave, NGW = F.G * NWAVES;
    for (int au = gw; au < NBATCH * 4 * 64 * 4; au += NGW) {
        const int g = au & 3, qb = (au >> 2) & 63, kvh = (au >> 8) & 3, b = au >> 10, h = kvh * 4 + g;
        attn_wave_unit(b, h, qb, Q, Kb, Vp, mix, F.in[8][h] * LOG2E, F.lane);
    }
    for (int su = gw; su < MS * 16; su += NGW) { const int sb = su >> 4, h = su & 15; sample_attn_unit(sb, h, F, Q, mix, (h & 3) == 0); }
    for (int su = NGW - 1 - gw; su < MS; su += NGW) sample_conv_unit(su, F, mix);
    { const int gt = blockIdx.x * (NWAVES * 64) + F.tid, NGT = F.G * NWAVES * 64; v4u* mp = (v4u*)(mix + (size_t)MR * DM);
      for (int i = gt; i < (RPAD - MR) * DM / 8; i += NGT) mp[i] = (v4u){0u, 0u, 0u, 0u}; }
}

__device__ __forceinline__ void p6_final(Frame& F) {
    const int gw = blockIdx.x * NWAVES + F.wave, NGW = F.G * NWAVES;
    const float* rs2 = (const float*)(F.ws + WS_ROWSS2); const float* gf = F.in[18];
    f32x4 g[8];
#pragma unroll
    for (int j = 0; j < 8; ++j) g[j] = *((const f32x4*)gf + F.lane + 64 * j);
    for (int m = gw; m < MR; m += NGW) {
        const float r = 1.0f / sqrtf(rs2[m] * (1.0f / DM) + EPS);
        f32x4* xr = (f32x4*)(F.out + (size_t)m * DM) + F.lane;
#pragma unroll
        for (int j = 0; j < 8; ++j) { const f32x4 v = xr[64 * j]; xr[64 * j] = v * r * g[j]; }
    }
}

constexpr int NPHASE = 7;
struct Args { const float* in[19]; float* out; unsigned char* ws; int ph_lo, ph_hi; };
__global__ void __launch_bounds__(NWAVES * 64, 2) mk_fwd(Args args) {
    extern __shared__ __attribute__((aligned(16))) unsigned char lds[];
    Frame F;
    F.lds = (LAS unsigned char*)lds;
    F.tid = threadIdx.x; F.lane = F.tid & 63; F.wave = __builtin_amdgcn_readfirstlane(F.tid >> 6); F.G = gridDim.x;
#pragma unroll
    for (int i = 0; i < 19; ++i) F.in[i] = args.in[i];
    F.out = args.out; F.ws = args.ws;
    const int lo = args.ph_lo, hi = args.ph_hi;
#define IN(k) (lo <= (k) && (k) < hi)
#define SEAM(k) do { if (IN(k) && IN((k) + 1)) { cg::this_grid().sync(); } } while (0)
    bf16* Win = (bf16*)(F.ws + WS_WIN); bf16* Wout = (bf16*)(F.ws + WS_WOUT); bf16* Wup = (bf16*)(F.ws + WS_WUP); bf16* Wdn = (bf16*)(F.ws + WS_WDN);
    bf16* XA = (bf16*)(F.ws + WS_A); bf16* HB = (bf16*)(F.ws + WS_HB); bf16* ACT = (bf16*)(F.ws + WS_ACT);
    float* rowss = (float*)(F.ws + WS_ROWSS); float* rowss2 = (float*)(F.ws + WS_ROWSS2);

    if (IN(0)) { p0_prologue(F); }
    SEAM(0);
    if (IN(1)) {
        pg8::Gemm g{XA, Win, RPAD, IN_DIM, DM}; pg8::StaticOrder S; S.init(RPAD, IN_DIM, F.G, (int)blockIdx.x);
        pg8::EpiIn E{(bf16*)(F.ws + WS_Q), (bf16*)(F.ws + WS_K), (bf16*)(F.ws + WS_V), (bf16*)(F.ws + WS_U), (const float*)(F.ws + WS_BPERM), (const float*)(F.ws + WS_ROPE), F.out};
        pg8::gemm_phase<pg8::EpiIn, pg8::StaticOrder, true, true>(F.lds + RING_OFF, g, S, E);
    }
    SEAM(1);
    if (IN(2)) { p2_mixers(F); }
    SEAM(2);
    if (IN(3)) {
        pg8::Gemm g{XA, Wout, RPAD, DM, DM}; pg8::StaticOrder S; S.init(RPAD, DM, F.G, (int)blockIdx.x);
        pg8::EpiOut E{F.in[0], F.in[1], F.in[14], F.out, HB, rowss};
        pg8::gemm_phase<pg8::EpiOut, pg8::StaticOrder, true, true>(F.lds + RING_OFF, g, S, E);
    }
    SEAM(3);
    if (IN(4)) {
        pg8::Gemm g{HB, Wup, RPAD, DFF, DM}; pg8::StaticOrder S; S.init(RPAD, DFF, F.G, (int)blockIdx.x);
        pg8::EpiUp E{ACT, rowss};
        pg8::gemm_phase<pg8::EpiUp, pg8::StaticOrder, true, true>(F.lds + RING_OFF, g, S, E);
    }
    SEAM(4);
    if (IN(5)) {
        pg8::Gemm g{ACT, Wdn, RPAD, DM, DFF}; pg8::StaticOrder S; S.init(RPAD, DM, F.G, (int)blockIdx.x);
        pg8::EpiDown E{F.out, rowss2};
        pg8::gemm_phase<pg8::EpiDown, pg8::StaticOrder, true, true>(F.lds + RING_OFF, g, S, E);
    }
    SEAM(5);
    if (IN(6)) { p6_final(F); }
#undef IN
#undef SEAM
}

extern "C" void kernel_launch(void* const* d_in, const int* in_sizes, int n_in, void* d_out, int out_size, void* d_ws, size_t ws_size, hipStream_t stream) {
    static int grid = 0;
    if (grid == 0) {
        int dev = 0, cus = 0, per_cu = 0;
        (void)hipGetDevice(&dev);
        (void)hipDeviceGetAttribute(&cus, hipDeviceAttributeMultiprocessorCount, dev);
        if (hipFuncSetAttribute((const void*)mk_fwd, hipFuncAttributeMaxDynamicSharedMemorySize, LDS_BYTES) != hipSuccess) fprintf(stderr, "kernel_launch: hipFuncSetAttribute failed\n");
        if (hipOccupancyMaxActiveBlocksPerMultiprocessor(&per_cu, (const void*)mk_fwd, NWAVES * 64, LDS_BYTES) != hipSuccess || per_cu < 1) per_cu = 1;
        (void)hipGetLastError();
        if (cus <= 0) cus = 256;
        grid = cus * per_cu;
        if (n_in != 19 || ws_size < 1024 * MiB) fprintf(stderr, "kernel_launch: unexpected n_in %d / ws_size %zu\n", n_in, ws_size);
    }
    Args a{};
    for (int i = 0; i < 19; ++i) a.in[i] = (const float*)d_in[i];
    a.out = (float*)d_out; a.ws = (unsigned char*)d_ws;
#if MK_LAUNCHES == 1
    a.ph_lo = 0; a.ph_hi = NPHASE;
    void* params[] = {&a};
    hipError_t e = hipLaunchCooperativeKernel((const void*)mk_fwd, dim3(grid), dim3(NWAVES * 64), params, LDS_BYTES, stream);
    if (e != hipSuccess) fprintf(stderr, "cooperative launch failed: %s (grid %d)\n", hipGetErrorString(e), grid);
#else
    for (int p = 0; p < NPHASE; ++p) {
        a.ph_lo = p; a.ph_hi = p + 1;
        hipLaunchKernelGGL(mk_fwd, dim3(grid), dim3(NWAVES * 64), LDS_BYTES, stream, a);
    }
#endif
}
```

```cpp
#include <hip/hip_runtime.h>
#include <hip/hip_cooperative_groups.h>
#include <cstdio>
#include <cstdint>
namespace cg = cooperative_groups;

#ifndef PROBE_REP
#define PROBE_REP -1
#endif
#ifndef MK_LAUNCHES
#define MK_LAUNCHES 1
#endif

constexpr int DM = 2048, NBATCH = 16, SEQ = 2048, MP = NBATCH * SEQ, MS = 128, MR = MP + MS, RPAD = 33024;
constexpr int QD = 1024, KVD = 256, CCH = 1024, IN_DIM = 3584, DFF = 8192, CONVW = 31;
constexpr float EPS = 1e-5f;
constexpr float C2 = 0.125f * 1.4426950408889634f;
constexpr float LOG2E = 1.4426950408889634f;
constexpr size_t O_Y = 0, O_PK = 67371008, O_PV = 67895296, O_PC = 68419584, O_SK = 68911104, O_SV = 73105408, O_SC = 77299712;
constexpr size_t MiB = 1u << 20;
constexpr size_t WS_WIN = 0, WS_WOUT = 14 * MiB, WS_WUP = 22 * MiB, WS_WDN = 54 * MiB;
constexpr size_t WS_ROPE = 86 * MiB, WS_BPERM = 86 * MiB + 256 * 1024, WS_ROWSS = 86 * MiB + 512 * 1024, WS_ROWSS2 = 86 * MiB + 768 * 1024;
constexpr size_t WS_PART = 87 * MiB;
constexpr size_t WS_A = 90 * MiB;
constexpr size_t WS_Q = 219 * MiB;
constexpr size_t WS_K = WS_Q + (size_t)RPAD * 1024 * 2;
constexpr size_t WS_V = WS_K + (size_t)RPAD * 256 * 2;
constexpr size_t WS_U = WS_V + (size_t)RPAD * 256 * 2;
constexpr size_t WS_HB = WS_Q;
constexpr size_t WS_ACT = 381 * MiB;
static_assert(WS_U + (size_t)RPAD * 1024 * 2 <= WS_ACT && WS_HB + (size_t)RPAD * 2048 * 2 <= WS_ACT, "ws map");
static_assert(WS_ACT + (size_t)RPAD * 8192 * 2 <= 1024 * MiB, "ws map end");

namespace pg8 {
#define PG8_LAS __attribute__((address_space(3)))
typedef unsigned short bf16_t;
typedef short bf16x8 __attribute__((ext_vector_type(8)));
typedef float f32x4 __attribute__((ext_vector_type(4)));
typedef unsigned u32x4 __attribute__((ext_vector_type(4)));
constexpr int BM = 256, BK = 64, HALF = 128, HTB = HALF * BK * 2  , STAGE_BYTES = 8 * HTB, NXCD = 8, WGM = 8;

__host__ __device__ __forceinline__ int lds_byte(int r, int c) { const int st = (r >> 4) * 2 + (c >> 5), rr = r & 15, cc = c & 31, ob = rr * 64 + cc * 2; return st * 1024 + (ob ^ (((ob >> 9) & 1) << 5)); }
__host__ __device__ __forceinline__ void stage_rc(int b, int& R, int& C) { const int st = b / 1024, sb = b % 1024, swz = sb ^ (((sb >> 9) & 1) << 5); R = (st >> 1) * 16 + swz / 64; C = (st & 1) * 32 + (swz % 64) / 2; }
__host__ __device__ __forceinline__ int perm32(int rho) { const int n = rho >> 4, i = rho & 15; return 8 * (i >> 2) + 4 * n + (i & 3); }

struct Unit { int pm, pn; };
struct Gemm { const bf16_t* A; const bf16_t* Bt; int M, N, K; };

struct StaticOrder {
    int nM, nN, nwg, G, c;
    __host__ __device__ void init(int M, int N, int G_, int c_) { nM = M / BM; nN = N / BM; nwg = nM * nN; G = G_; c = c_; }
    __host__ __device__ bool next(int i, Unit& u) const {
        const long L = (long)i * G + c; if (L >= nwg) return false;
        int wgid = (int)L; { const int q = nwg / NXCD, r = nwg % NXCD, xcd = wgid % NXCD, off = wgid / NXCD; wgid = (xcd < r ? xcd * (q + 1) : r * (q + 1) + (xcd - r) * q) + off; }
        const int nig = WGM * nN, gid = wgid / nig, fm = gid * WGM, gsz = (nM - fm) < WGM ? (nM - fm) : WGM;
        u.pm = fm + ((wgid % nig) % gsz); u.pn = (wgid % nig) / gsz; return true;
    }
    __device__ __forceinline__ void a_ready(const Unit&) const {}
    __device__ __forceinline__ void done(const Unit&) const {}
};

typedef float f32x2_t __attribute__((ext_vector_type(2)));
typedef __bf16 bf16x2_t __attribute__((ext_vector_type(2)));
__device__ __forceinline__ unsigned pk2(float lo, float hi) { f32x2_t v = {lo, hi}; bf16x2_t b = __builtin_convertvector(v, bf16x2_t); return __builtin_bit_cast(unsigned, b); }
__device__ __forceinline__ u32x4 pk8(const f32x4& a, const f32x4& b) { u32x4 w; w.x = pk2(a[0], a[1]); w.y = pk2(a[2], a[3]); w.z = pk2(b[0], b[1]); w.w = pk2(b[2], b[3]); return w; }
__device__ __forceinline__ float sumsq8(const f32x4& a, const f32x4& b) { return ((a[0] * a[0] + a[1] * a[1]) + (a[2] * a[2] + a[3] * a[3])) + ((b[0] * b[0] + b[1] * b[1]) + (b[2] * b[2] + b[3] * b[3])); }

struct EpiIn {
    static constexpr bool PERM = true, AFTER_DRAIN = false;
    bf16_t *Q, *Kb, *Vp, *U; const float* bias; const float* rope; float* out;
    __device__ __forceinline__ void operator()(const f32x4 (&acc)[2][2][4][2], const Unit& u, int wr, int wc, int fr, int fq) const {
        const int pn = u.pn, colw = wc * 32 + 8 * fq;
        f32x4 bv[2][2];
#pragma unroll
        for (int bj = 0; bj < 2; ++bj)
#pragma unroll
            for (int n = 0; n < 2; ++n) bv[bj][n] = *(const f32x4*)(bias + pn * 256 + bj * HALF + colw + 4 * n);
        const bool dorope = (pn < 5) && ((wc & 1) == 0);
#pragma unroll
        for (int ai = 0; ai < 2; ++ai)
#pragma unroll
            for (int m = 0; m < 4; ++m) {
                const int row = u.pm * BM + ai * HALF + wr * 64 + m * 16 + fr;
                const bool isP = row < MP, isS = (!isP) && row < MR;
                const int t = row & (SEQ - 1), b = row >> 11;
                if (pn >= 6) {
                    const int c = (pn - 6) * 128 + colw;
                    f32x4 o[2];
#pragma unroll
                    for (int n = 0; n < 2; ++n) {
                        const f32x4 val = acc[ai][0][m][n] + bv[0][n], gate = acc[ai][1][m][n] + bv[1][n];
#pragma unroll
                        for (int e = 0; e < 4; ++e) o[n][e] = val[e] * __builtin_amdgcn_rcpf(1.0f + __expf(-gate[e]));
                    }
                    *(u32x4*)(U + (size_t)row * CCH + c) = pk8(o[0], o[1]);
                    float* dst = nullptr;
                    if (isP && t >= SEQ - 30) dst = out + O_PC + ((size_t)(b * 30 + t - (SEQ - 30))) * CCH + c;
                    if (isS) dst = out + O_SC + ((size_t)((row - MP) * 30 + 29)) * CCH + c;
                    if (dst) { *(f32x4*)dst = o[0]; *(f32x4*)(dst + 4) = o[1]; }
                } else {
                    f32x4 c0, c1, s0, s1;
                    if (dorope) { const float* rp = rope + (size_t)(isP ? t : SEQ) * 16; c0 = *(const f32x4*)rp; c1 = *(const f32x4*)(rp + 4); s0 = *(const f32x4*)(rp + 8); s1 = *(const f32x4*)(rp + 12);
                        if (fq == 0) { s0 = -s0; s1 = -s1; } }
#pragma unroll
                    for (int bj = 0; bj < 2; ++bj) {
                        f32x4 v0 = acc[ai][bj][m][0] + bv[bj][0], v1 = acc[ai][bj][m][1] + bv[bj][1];
                        if (dorope) {
                            f32x4 p0, p1;
#pragma unroll
                            for (int e = 0; e < 4; ++e) { p0[e] = __shfl_xor(v0[e], 16); p1[e] = __shfl_xor(v1[e], 16); }
                            if (fq < 2) { v0 = v0 * c0 + p0 * s0; v1 = v1 * c1 + p1 * s1; }
                        }
                        const int col = bj * HALF + colw;
                        const u32x4 w = pk8(v0, v1);
                        if (pn < 4) { *(u32x4*)(Q + (size_t)row * QD + pn * 256 + col) = w; }
                        else {
                            if (pn == 4) { *(u32x4*)(Kb + (size_t)row * KVD + col) = w; }
                            else if (isP) {
                                const int kvh = col >> 6, d = col & 63, kb = t >> 5, kap = t & 31;
                                const int i = kap & 3, hh = (kap >> 2) & 1, j = kap >> 3, s = j >> 1, e0 = 4 * (j & 1) + i;
                                bf16_t* vp = Vp + (size_t)(b * 4 + kvh) * (SEQ * 64) + (size_t)((((kb * 2 + (d >> 5)) * 2 + s) * 2 + hh) * 256) + (d & 31) * 8 + e0;
                                vp[0] = (bf16_t)(w.x & 0xffffu); vp[8] = (bf16_t)(w.x >> 16); vp[16] = (bf16_t)(w.y & 0xffffu); vp[24] = (bf16_t)(w.y >> 16);
                                vp[32] = (bf16_t)(w.z & 0xffffu); vp[40] = (bf16_t)(w.z >> 16); vp[48] = (bf16_t)(w.w & 0xffffu); vp[56] = (bf16_t)(w.w >> 16);
                            }
                            float* dst = nullptr;
                            if (isP && t >= SEQ - 128) dst = out + (pn == 4 ? O_PK : O_PV) + ((size_t)(b * 128 + t - (SEQ - 128))) * KVD + col;
                            if (isS) dst = out + (pn == 4 ? O_SK : O_SV) + ((size_t)((row - MP) * 128 + 127)) * KVD + col;
                            if (dst) { *(f32x4*)dst = v0; *(f32x4*)(dst + 4) = v1; }
                        }
                    }
                }
            }
    }
};

struct EpiOut {
    static constexpr bool PERM = true, AFTER_DRAIN = false;
    const float *xp, *bias; bf16_t* HB; float* rowss;
    __device__ __forceinline__ void operator()(const f32x4 (&acc)[2][2][4][2], const Unit& u, int wr, int wc, int fr, int fq) const {
        const int colb = u.pn * BM + wc * 32 + 8 * fq;
        f32x4 bv[2][2];
#pragma unroll
        for (int bj = 0; bj < 2; ++bj)
#pragma unroll
            for (int n = 0; n < 2; ++n) bv[bj][n] = *(const f32x4*)(bias + colb + bj * HALF + 4 * n);
#pragma unroll
        for (int ai = 0; ai < 2; ++ai)
#pragma unroll
            for (int m = 0; m < 4; ++m) {
                const int row = u.pm * BM + ai * HALF + wr * 64 + m * 16 + fr;
                const float* xr = xp + (size_t)row * DM;
                float ss = 0.f;
#pragma unroll
                for (int bj = 0; bj < 2; ++bj) {
                    const int col = colb + bj * HALF;
                    const f32x4 v0 = acc[ai][bj][m][0] + bv[bj][0] + *(const f32x4*)(xr + col), v1 = acc[ai][bj][m][1] + bv[bj][1] + *(const f32x4*)(xr + col + 4);
                    *(u32x4*)(HB + (size_t)row * DM + col) = pk8(v0, v1);
                    ss += sumsq8(v0, v1);
                }
                ss += __shfl_xor(ss, 16); ss += __shfl_xor(ss, 32);
                if (fq == 0) unsafeAtomicAdd(rowss + row, ss);
            }
    }
};

struct EpiUp {
    static constexpr bool PERM = true, AFTER_DRAIN = false;
    bf16_t* ACT; const float* rowss;
    __device__ __forceinline__ void operator()(const f32x4 (&acc)[2][2][4][2], const Unit& u, int wr, int wc, int fr, int fq) const {
        const int colb = u.pn * BM + wc * 32 + 8 * fq;
#pragma unroll
        for (int ai = 0; ai < 2; ++ai)
#pragma unroll
            for (int m = 0; m < 4; ++m) {
                const int row = u.pm * BM + ai * HALF + wr * 64 + m * 16 + fr;
                const float rr = 1.0f / (rowss[row] * (1.0f / DM) + EPS);
#pragma unroll
                for (int bj = 0; bj < 2; ++bj) {
                    f32x4 v0 = acc[ai][bj][m][0], v1 = acc[ai][bj][m][1];
#pragma unroll
                    for (int e = 0; e < 4; ++e) { const float a = fmaxf(v0[e], 0.f), c = fmaxf(v1[e], 0.f); v0[e] = a * a * rr; v1[e] = c * c * rr; }
                    *(u32x4*)(ACT + (size_t)row * DFF + colb + bj * HALF) = pk8(v0, v1);
                }
            }
    }
};

__device__ __forceinline__ f32x4 bfx4_lo(const u32x4& w) { return (f32x4){__uint_as_float(w.x << 16), __uint_as_float(w.x & 0xffff0000u), __uint_as_float(w.y << 16), __uint_as_float(w.y & 0xffff0000u)}; }
__device__ __forceinline__ f32x4 bfx4_hi(const u32x4& w) { return (f32x4){__uint_as_float(w.z << 16), __uint_as_float(w.z & 0xffff0000u), __uint_as_float(w.w << 16), __uint_as_float(w.w & 0xffff0000u)}; }
struct EpiDown {
    static constexpr bool PERM = true, AFTER_DRAIN = false;
    const bf16_t* HB; bf16_t* YB; float* rowss;
    __device__ __forceinline__ void operator()(const f32x4 (&acc)[2][2][4][2], const Unit& u, int wr, int wc, int fr, int fq) const {
        const int colb = u.pn * BM + wc * 32 + 8 * fq;
#pragma unroll
        for (int ai = 0; ai < 2; ++ai)
#pragma unroll
            for (int m = 0; m < 4; ++m) {
                const int row = u.pm * BM + ai * HALF + wr * 64 + m * 16 + fr;
                float ss = 0.f;
#pragma unroll
                for (int bj = 0; bj < 2; ++bj) {
                    const size_t off = (size_t)row * DM + colb + bj * HALF;
                    const u32x4 hw = *(const u32x4*)(HB + off);
                    const f32x4 v0 = acc[ai][bj][m][0] + bfx4_lo(hw), v1 = acc[ai][bj][m][1] + bfx4_hi(hw);
                    *(u32x4*)(YB + off) = pk8(v0, v1);
                    ss += sumsq8(v0, v1);
                }
                ss += __shfl_xor(ss, 16); ss += __shfl_xor(ss, 32);
                if (fq == 0) unsafeAtomicAdd(rowss + row, ss);
            }
    }
};

template <class Epi, class Sched, bool ALIGN_EPI = false, bool SP2 = false>
__device__ __forceinline__ void gemm_phase(PG8_LAS unsigned char* lds, const Gemm g, const Sched& S, const Epi& E) {
    const int tid = threadIdx.x, wid = __builtin_amdgcn_readfirstlane(tid >> 6), lane = tid & 63, wr = wid >> 2, wc = wid & 3, fr = lane & 15, fq = lane >> 4;
    const int K = g.K, nt = K / BK;
    unsigned voffA[2], voffB[2];
#pragma unroll
    for (int i = 0; i < 2; ++i) { int R, C; stage_rc(tid * 16 + i * 8192, R, C); const int Rb = Epi::PERM ? ((R & ~31) + perm32(R & 31)) : R;
        voffA[i] = (unsigned)(R * K + C) * 2u; voffB[i] = (unsigned)(Rb * K + C) * 2u; }
    const size_t kstep = (size_t)(BK * 2);
    const size_t hstep = (size_t)HALF * K * 2;
    const size_t tstep = 2 * hstep;
    const unsigned ldsw = (unsigned)wid * 1024u;
    const int aoff = lds_byte(wr * 64 + fr, fq * 8), boff = lds_byte(wc * 32 + fr, fq * 8);
#define PG8_SA(b, h) (((b) * 2 + (h)) * HTB)
#define PG8_SB(b, h) ((4 + (b) * 2 + (h)) * HTB)
#define PG8_STAGE(bufoff, gbase, voff) do { _Pragma("unroll") for (int _i = 0; _i < 2; ++_i) \
        __builtin_amdgcn_global_load_lds((const unsigned*)((const char*)(gbase) + (voff)[_i]), (PG8_LAS unsigned*)(lds + (bufoff) + ldsw + _i * 8192), 16, 0, 0); } while (0)
#define PG8_LDA(dst, b, h) do { _Pragma("unroll") for (int m = 0; m < 4; ++m) _Pragma("unroll") for (int k = 0; k < 2; ++k) dst[m][k] = *(const PG8_LAS bf16x8*)(lds + PG8_SA(b, h) + aoff + m * 2048 + k * 1024); } while (0)
#define PG8_LDB(dst, b, h) do { _Pragma("unroll") for (int n = 0; n < 2; ++n) _Pragma("unroll") for (int k = 0; k < 2; ++k) dst[n][k] = *(const PG8_LAS bf16x8*)(lds + PG8_SB(b, h) + boff + n * 2048 + k * 1024); } while (0)
#define PG8_MMA(ai, bj, At, Bt) do { __builtin_amdgcn_s_setprio(1); _Pragma("unroll") for (int m = 0; m < 4; ++m) _Pragma("unroll") for (int n = 0; n < 2; ++n) _Pragma("unroll") for (int k = 0; k < 2; ++k) \
        acc[ai][bj][m][n] = __builtin_amdgcn_mfma_f32_16x16x32_bf16(Bt[n][k], At[m][k], acc[ai][bj][m][n], 0, 0, 0); __builtin_amdgcn_s_setprio(0); } while (0)
#define PG8_WAIT_V(n) asm volatile("s_waitcnt vmcnt(" #n ")" ::: "memory")
#define PG8_WAIT_L(n) asm volatile("s_waitcnt lgkmcnt(" #n ")" ::: "memory")
#define PG8_BAR __builtin_amdgcn_s_barrier()
#define PG8_SCHED __builtin_amdgcn_sched_barrier(0)
    Unit cur, nxt; int ui = 0;
    if (!S.next(0, cur)) return;
    f32x4 acc[2][2][4][2];
#pragma unroll
    for (int a = 0; a < 2; ++a)
#pragma unroll
        for (int b = 0; b < 2; ++b)
#pragma unroll
            for (int m = 0; m < 4; ++m)
#pragma unroll
                for (int n = 0; n < 2; ++n) acc[a][b][m][n] = (f32x4){0.f, 0.f, 0.f, 0.f};
    bf16x8 At[4][2], B0[2][2], B1[2][2];
    const char* cA = (const char*)g.A + (size_t)cur.pm * tstep; const char* cB = (const char*)g.Bt + (size_t)cur.pn * tstep;
    S.a_ready(cur);
    if constexpr (SP2) {
        PG8_STAGE(PG8_SB(0, 0), cB, voffB); PG8_STAGE(PG8_SB(0, 1), cB + hstep, voffB); PG8_STAGE(PG8_SA(0, 0), cA, voffA); PG8_STAGE(PG8_SA(0, 1), cA + hstep, voffA);
        if (wr == 1) PG8_BAR;
        PG8_WAIT_V(2); PG8_BAR;
        PG8_STAGE(PG8_SB(1, 0), cB + kstep, voffB); PG8_STAGE(PG8_SA(1, 0), cA + kstep, voffA); PG8_STAGE(PG8_SB(1, 1), cB + hstep + kstep, voffB);
        PG8_WAIT_V(6); PG8_BAR;
    } else {
        PG8_STAGE(PG8_SB(0, 0), cB, voffB); PG8_STAGE(PG8_SA(0, 0), cA, voffA); PG8_STAGE(PG8_SB(0, 1), cB + hstep, voffB); PG8_STAGE(PG8_SA(0, 1), cA + hstep, voffA);
        if (wr == 1) PG8_BAR;
        PG8_WAIT_V(4); PG8_BAR;
        PG8_STAGE(PG8_SB(1, 0), cB + kstep, voffB); PG8_STAGE(PG8_SA(1, 0), cA + kstep, voffA); PG8_STAGE(PG8_SB(1, 1), cB + hstep + kstep, voffB);
        PG8_WAIT_V(6); PG8_BAR;
    }
    for (;;) {
        const bool has_next = S.next(ui + 1, nxt);
        const char* nA = has_next ? (const char*)g.A + (size_t)nxt.pm * tstep : cA; const char* nB = has_next ? (const char*)g.Bt + (size_t)nxt.pn * tstep : cB;
        for (int t = 0; t < nt; t += 2) {
            const bool last = (t == nt - 2);
            const char* a1 = cA + (size_t)(t + 1) * kstep;
            const char* a2 = last ? nA : cA + (size_t)(t + 2) * kstep; const char* b2 = last ? nB : cB + (size_t)(t + 2) * kstep;
            const char* a3 = a2 + kstep; const char* b3 = b2 + kstep;
            if (last && has_next) S.a_ready(nxt);
            if constexpr (SP2) {
            PG8_LDB(B0, 0, 0); PG8_LDB(B1, 0, 1); PG8_SCHED; PG8_LDA(At, 0, 0); PG8_STAGE(PG8_SA(1, 1), a1 + hstep, voffA);
            PG8_WAIT_V(8); PG8_WAIT_L(0); PG8_BAR; PG8_MMA(0, 0, At, B0); PG8_MMA(0, 1, At, B1); PG8_BAR; PG8_SCHED;
            PG8_LDA(At, 0, 1); PG8_STAGE(PG8_SB(0, 0), b2, voffB); PG8_STAGE(PG8_SB(0, 1), b2 + hstep, voffB); PG8_STAGE(PG8_SA(0, 0), a2, voffA);
            PG8_WAIT_V(8); PG8_WAIT_L(0); PG8_BAR; PG8_MMA(1, 0, At, B0); PG8_MMA(1, 1, At, B1); PG8_BAR; PG8_SCHED;
            PG8_LDB(B0, 1, 0); PG8_LDB(B1, 1, 1); PG8_SCHED; PG8_LDA(At, 1, 0); PG8_STAGE(PG8_SA(0, 1), a2 + hstep, voffA);
            PG8_WAIT_V(8); PG8_WAIT_L(0); PG8_BAR; PG8_MMA(0, 0, At, B0); PG8_MMA(0, 1, At, B1); PG8_BAR; PG8_SCHED;
            PG8_LDA(At, 1, 1); PG8_STAGE(PG8_SB(1, 0), b3, voffB); PG8_STAGE(PG8_SB(1, 1), b3 + hstep, voffB); PG8_STAGE(PG8_SA(1, 0), a3, voffA);
            PG8_WAIT_V(8); PG8_WAIT_L(0); PG8_BAR; PG8_MMA(1, 0, At, B0); PG8_MMA(1, 1, At, B1); PG8_BAR; PG8_SCHED;
            } else {
            PG8_LDB(B0, 0, 0); PG8_SCHED; PG8_LDA(At, 0, 0); PG8_STAGE(PG8_SA(1, 1), a1 + hstep, voffA);
            PG8_WAIT_L(8); PG8_BAR; PG8_WAIT_L(0); PG8_MMA(0, 0, At, B0); PG8_BAR; PG8_SCHED;
            PG8_LDB(B1, 0, 1); PG8_STAGE(PG8_SB(0, 0), b2, voffB);
            PG8_BAR; PG8_WAIT_L(0); PG8_MMA(0, 1, At, B1); PG8_BAR;
            PG8_LDA(At, 0, 1); PG8_STAGE(PG8_SA(0, 0), a2, voffA);
            PG8_BAR; PG8_WAIT_L(0); PG8_MMA(1, 0, At, B0); PG8_BAR; PG8_SCHED;
            PG8_STAGE(PG8_SB(0, 1), b2 + hstep, voffB);
            PG8_WAIT_V(6); PG8_BAR; PG8_MMA(1, 1, At, B1); PG8_BAR;
            PG8_LDB(B0, 1, 0); PG8_SCHED; PG8_LDA(At, 1, 0); PG8_STAGE(PG8_SA(0, 1), a2 + hstep, voffA);
            PG8_WAIT_L(8); PG8_BAR; PG8_WAIT_L(0); PG8_MMA(0, 0, At, B0); PG8_BAR; PG8_SCHED;
            PG8_LDB(B1, 1, 1); PG8_STAGE(PG8_SB(1, 0), b3, voffB);
            PG8_BAR; PG8_WAIT_L(0); PG8_MMA(0, 1, At, B1); PG8_BAR;
            PG8_LDA(At, 1, 1); PG8_STAGE(PG8_SA(1, 0), a3, voffA);
            PG8_BAR; PG8_WAIT_L(0); PG8_MMA(1, 0, At, B0); PG8_BAR; PG8_SCHED;
            PG8_STAGE(PG8_SB(1, 1), b3 + hstep, voffB);
            PG8_WAIT_V(6); PG8_BAR; PG8_MMA(1, 1, At, B1); PG8_BAR;
            }
        }
        if constexpr (ALIGN_EPI) { if (wr == 0) PG8_BAR; }
        if constexpr (!Epi::AFTER_DRAIN) { E(acc, cur, wr, wc, fr, fq); S.done(cur); }
        if (!has_next) break;
#pragma unroll
        for (int a = 0; a < 2; ++a)
#pragma unroll
            for (int b = 0; b < 2; ++b)
#pragma unroll
                for (int m = 0; m < 4; ++m)
#pragma unroll
                    for (int n = 0; n < 2; ++n) acc[a][b][m][n] = (f32x4){0.f, 0.f, 0.f, 0.f};
        cur = nxt; cA = nA; cB = nB; ++ui;
        if constexpr (ALIGN_EPI) { if (wr == 1) PG8_BAR; }
    }
    PG8_WAIT_V(0);
    if constexpr (!ALIGN_EPI) { if (wr == 0) PG8_BAR; }
    PG8_BAR;
    if constexpr (Epi::AFTER_DRAIN) { E.fused(acc, cur, wr, wc, fr, fq, lds, wid, lane); S.done(cur); }
#undef PG8_SA
#undef PG8_SB
#undef PG8_STAGE
#undef PG8_LDA
#undef PG8_LDB
#undef PG8_MMA
#undef PG8_WAIT_V
#undef PG8_WAIT_L
#undef PG8_BAR
#undef PG8_SCHED
}
}

constexpr int RING_OFF = 0, RING_BYTES = 131072;
constexpr int LDS_BYTES = 147456;
constexpr int NWAVES = 8;
#define LAS __attribute__((address_space(3)))
typedef unsigned short bf16;
typedef unsigned v4u __attribute__((ext_vector_type(4)));
typedef unsigned v2u __attribute__((ext_vector_type(2)));
typedef float f32x4 __attribute__((ext_vector_type(4)));
typedef float f32x16 __attribute__((ext_vector_type(16)));
typedef short bf16x8 __attribute__((ext_vector_type(8)));
#define LDS_WAIT() asm volatile("s_waitcnt lgkmcnt(0)" ::: "memory")
using pg8::pk2;

__device__ __forceinline__ float wave_sum(float v) {
#pragma unroll
    for (int o = 1; o < 64; o <<= 1) v += __shfl_xor(v, o);
    return v;
}
__device__ __forceinline__ float wave_max(float v) {
#pragma unroll
    for (int o = 1; o < 64; o <<= 1) v = fmaxf(v, __shfl_xor(v, o));
    return v;
}
__device__ __forceinline__ float bf_lo(unsigned x) { return __uint_as_float(x << 16); }
__device__ __forceinline__ float bf_hi(unsigned x) { return __uint_as_float(x & 0xffff0000u); }

struct Frame {
    LAS unsigned char* lds;
    int tid, lane, wave, G;
    const float* in[19]; float* out; unsigned char* ws;
};

__device__ __forceinline__ void p0_transpose_item(const float* W, int K, int N, bf16* WT, int k0, int n0, int drow0, const float* kscale, LAS float* scr, int lane) {
#pragma unroll 8
    for (int i = 0; i < 32; ++i) { const int kk = 2 * i + (lane >> 5); float v = W[(size_t)(k0 + kk) * N + n0 + (lane & 31)]; if (kscale) v *= kscale[k0 + kk]; scr[kk * 33 + (lane & 31)] = v; }
    LDS_WAIT(); asm volatile("" ::: "memory");
    const int c = lane & 7;
#pragma unroll
    for (int j = 0; j < 4; ++j) { const int n = (lane >> 3) + 8 * j; const LAS float* s = scr + (8 * c) * 33 + n;
        v4u o; o.x = pk2(s[0 * 33], s[1 * 33]); o.y = pk2(s[2 * 33], s[3 * 33]); o.z = pk2(s[4 * 33], s[5 * 33]); o.w = pk2(s[6 * 33], s[7 * 33]);
        *(v4u*)(WT + (size_t)(drow0 + n) * K + k0 + 8 * c) = o; }
    LDS_WAIT(); asm volatile("" ::: "memory");
}
__device__ __forceinline__ int inproj_row(int n) {
    if (n < 1536) return n;
    if (n < 2560) { const int c = n - 1536; return 1536 + (c >> 7) * 256 + (c & 127); }
    const int c = n - 2560; return 1536 + (c >> 7) * 256 + 128 + (c & 127);
}
__device__ __forceinline__ void sincos_acc(float ang, float& c, float& s) {
    const double x = (double)ang;
    const double n = rint(x * 0.63661977236758134308);
    double r = fma(-n, 1.57079632679489655800, x); r = fma(-n, 6.12323399573676603587e-17, r);
    const int q = ((int)n) & 3;
    const double r2 = r * r;
    const double sp = r * (1.0 + r2 * (-1.0 / 6 + r2 * (1.0 / 120 + r2 * (-1.0 / 5040 + r2 * (1.0 / 362880 + r2 * (-1.0 / 39916800 + r2 * (1.0 / 6227020800.0)))))));
    const double cp = 1.0 + r2 * (-0.5 + r2 * (1.0 / 24 + r2 * (-1.0 / 720 + r2 * (1.0 / 40320 + r2 * (-1.0 / 3628800 + r2 * (1.0 / 479001600 + r2 * (-1.0 / 87178291200.0)))))));
    const double ss = (q == 0) ? sp : (q == 1) ? cp : (q == 2) ? -sp : -cp;
    const double cc = (q == 0) ? cp : (q == 1) ? -sp : (q == 2) ? -cp : sp;
    c = (float)cc; s = (float)ss;
}
__device__ __forceinline__ void p0_prologue(Frame& F) {
    LAS float* scr = (LAS float*)(F.lds + RING_OFF + F.wave * 16384);
    const int gw = blockIdx.x * NWAVES + F.wave, NGW = F.G * NWAVES;
    const int gt = blockIdx.x * (NWAVES * 64) + F.tid, NGT = F.G * NWAVES * 64;
    bf16* Win = (bf16*)(F.ws + WS_WIN); bf16* Wout = (bf16*)(F.ws + WS_WOUT); bf16* Wup = (bf16*)(F.ws + WS_WUP); bf16* Wdn = (bf16*)(F.ws + WS_WDN);
    { float* rope = (float*)(F.ws + WS_ROPE);
      for (int e = gt; e < (SEQ + 1) * 8; e += NGT) { const int p = e >> 3, i = e & 7; const float pos = (p < SEQ) ? (float)p : 16384.0f;
          const float invf[8] = {1.0f, 0.19392274474868576f, 0.03760603093086393f, 0.007292664737217109f, 0.001414213562373095f, 0.0002742481756762073f, 5.318295896944988e-05f, 1.031338537721246e-05f};
          float fsel = invf[0];
#pragma unroll
          for (int k = 1; k < 8; ++k) fsel = (i == k) ? invf[k] : fsel;
          const float ang = pos * fsel; float c, s; sincos_acc(ang, c, s); rope[p * 16 + i] = c; rope[p * 16 + 8 + i] = s; }
      float* bperm = (float*)(F.ws + WS_BPERM); const float* b_in = F.in[7];
      for (int n = gt; n < IN_DIM; n += NGT) bperm[inproj_row(n)] = b_in[n];
      float* rs = (float*)(F.ws + WS_ROWSS); float* rs2 = (float*)(F.ws + WS_ROWSS2);
      for (int r = gt; r < RPAD; r += NGT) { rs[r] = 0.f; rs2[r] = 0.f; } }
    constexpr int I_IN = (DM / 64) * (IN_DIM / 32), I_OUT = (DM / 64) * (DM / 32), I_UP = (DM / 64) * (DFF / 32), I_DN = (DFF / 64) * (DM / 32);
    constexpr int NITEMS = I_IN + I_OUT + I_UP + I_DN;
    for (int it = gw; it < NITEMS; it += NGW) {
        int r = it;
        if (r < I_IN) { const int nblk = IN_DIM / 32, kb = r / nblk, nb = r % nblk; p0_transpose_item(F.in[6], DM, IN_DIM, Win, 64 * kb, 32 * nb, inproj_row(32 * nb), nullptr, scr, F.lane); continue; } r -= I_IN;
        if (r < I_OUT) { const int nblk = DM / 32, kb = r / nblk, nb = r % nblk; p0_transpose_item(F.in[13], DM, DM, Wout, 64 * kb, 32 * nb, 32 * nb, nullptr, scr, F.lane); continue; } r -= I_OUT;
        if (r < I_UP) { const int nblk = DFF / 32, kb = r / nblk, nb = r % nblk; p0_transpose_item(F.in[16], DM, DFF, Wup, 64 * kb, 32 * nb, 32 * nb, F.in[15], scr, F.lane); continue; } r -= I_UP;
        { const int nblk = DM / 32, kb = r / nblk, nb = r % nblk; p0_transpose_item(F.in[17], DFF, DM, Wdn, 64 * kb, 32 * nb, 32 * nb, nullptr, scr, F.lane); }
    }
    bf16* XN = (bf16*)(F.ws + WS_A); const float* g1 = F.in[5];
    for (int m = gw; m < MR; m += NGW) {
        v2u* o8 = (v2u*)(XN + (size_t)m * DM) + F.lane;
        const float* xrow = m < MP ? F.in[0] + (size_t)m * DM : F.in[1] + (size_t)(m - MP) * DM;
        const f32x4* xr = (const f32x4*)xrow + F.lane;
        f32x4 v[8]; float s = 0.f;
#pragma unroll
        for (int j = 0; j < 8; ++j) { v[j] = xr[64 * j]; s += (v[j].x * v[j].x + v[j].y * v[j].y) + (v[j].z * v[j].z + v[j].w * v[j].w); }
        const float rstd = 1.0f / sqrtf(wave_sum(s) * (1.0f / DM) + EPS);
#pragma unroll
        for (int j = 0; j < 8; ++j) { const f32x4 g = *((const f32x4*)g1 + F.lane + 64 * j);
            o8[64 * j] = (v2u){pk2(v[j].x * rstd * g.x, v[j].y * rstd * g.y), pk2(v[j].z * rstd * g.z, v[j].w * rstd * g.w)}; }
    }
}

#define MFMA32(a, b, c) __builtin_amdgcn_mfma_f32_32x32x16_bf16((a), (b), (c), 0, 0, 0)
__device__ __forceinline__ int crow(int r, int hi) { return (r & 3) + 8 * (r >> 2) + 4 * hi; }

#define SCHED_BAR() __builtin_amdgcn_sched_barrier(0)
__device__ __forceinline__ void attn_wave_unit(int b, int h, int qb, const bf16* Q, const bf16* Kb, const bf16* Vp, bf16* mix, float sink2, int lane) {
    const int r32 = lane & 31, hi = lane >> 5, kvh = h >> 2, kb0 = qb - 4;
    const size_t row0 = (size_t)b * SEQ + qb * 32;
    bf16x8 qf[4], kf[5][4];
#pragma unroll
    for (int d0 = 0; d0 < 4; ++d0) qf[d0] = *(const bf16x8*)(Q + (row0 + r32) * QD + h * 64 + d0 * 16 + hi * 8);
#pragma unroll
    for (int jb = 0; jb < 5; ++jb) {
        const int kblk = (kb0 + jb) > 0 ? (kb0 + jb) : 0;
        const bf16* kp = Kb + ((size_t)b * SEQ + kblk * 32 + r32) * KVD + kvh * 64 + hi * 8;
#pragma unroll
        for (int d0 = 0; d0 < 4; ++d0) kf[jb][d0] = *(const bf16x8*)(kp + d0 * 16);
    }
    SCHED_BAR();
    f32x16 S[5];
#pragma unroll
    for (int jb = 0; jb < 5; ++jb) {
        f32x16 a;
#pragma unroll
        for (int r = 0; r < 16; ++r) a[r] = 0.f;
#pragma unroll
        for (int d0 = 0; d0 < 4; ++d0) a = MFMA32(kf[jb][d0], qf[d0], a);
        S[jb] = a;
    }
    SCHED_BAR();
    const bf16* vplane = Vp + (size_t)(b * 4 + kvh) * (SEQ * 64) + lane * 8;
    bf16x8 vf[5][2][2];
#pragma unroll
    for (int jb = 0; jb < 5; ++jb) {
        const int kblk = (kb0 + jb) > 0 ? (kb0 + jb) : 0;
#pragma unroll
        for (int s = 0; s < 2; ++s)
#pragma unroll
            for (int db = 0; db < 2; ++db) vf[jb][s][db] = *(const bf16x8*)(vplane + (size_t)((kblk * 2 + db) * 2 + s) * 512);
    }
    SCHED_BAR();
    float mx = sink2;
#pragma unroll
    for (int jb = 0; jb < 5; ++jb) {
        const bool blk_ok = (kb0 + jb) >= 0;
#pragma unroll
        for (int r = 0; r < 16; ++r) {
            float x = S[jb][r] * C2;
            bool ok = blk_ok;
            if (jb == 0) ok = ok && (crow(r, hi) > r32);
            if (jb == 4) ok = ok && (crow(r, hi) <= r32);
            x = ok ? x : -INFINITY;
            S[jb][r] = x; mx = fmaxf(mx, x);
        }
    }
    mx = fmaxf(mx, __shfl_xor(mx, 32));
    float l = 0.f;
#pragma unroll
    for (int jb = 0; jb < 5; ++jb)
#pragma unroll
        for (int r = 0; r < 16; ++r) { const float p = __builtin_amdgcn_exp2f(S[jb][r] - mx); S[jb][r] = p; l += p; }
    l += __shfl_xor(l, 32);
    l += __builtin_amdgcn_exp2f(sink2 - mx);
    f32x16 o[2];
#pragma unroll
    for (int r = 0; r < 16; ++r) { o[0][r] = 0.f; o[1][r] = 0.f; }
#pragma unroll
    for (int jb = 0; jb < 5; ++jb)
#pragma unroll
        for (int s = 0; s < 2; ++s) {
            v4u pw; pw.x = pk2(S[jb][8 * s + 0], S[jb][8 * s + 1]); pw.y = pk2(S[jb][8 * s + 2], S[jb][8 * s + 3]); pw.z = pk2(S[jb][8 * s + 4], S[jb][8 * s + 5]); pw.w = pk2(S[jb][8 * s + 6], S[jb][8 * s + 7]);
            const bf16x8 pf = __builtin_bit_cast(bf16x8, pw);
#pragma unroll
            for (int db = 0; db < 2; ++db) o[db] = MFMA32(vf[jb][s][db], pf, o[db]);
        }
    const float inv = 1.0f / l;
    bf16* orow = mix + (row0 + r32) * DM + h * 64 + 4 * hi;
#pragma unroll
    for (int db = 0; db < 2; ++db)
#pragma unroll
        for (int g4 = 0; g4 < 4; ++g4) {
            v2u w; w.x = pk2(o[db][4 * g4 + 0] * inv, o[db][4 * g4 + 1] * inv); w.y = pk2(o[db][4 * g4 + 2] * inv, o[db][4 * g4 + 3] * inv);
            *(v2u*)(orow + 32 * db + 8 * g4) = w;
        }
}

__device__ __forceinline__ void sample_attn_unit(int sb, int h, const Frame& F, const bf16* Q, bf16* mix, bool docopy) {
    const int lane = F.lane, kvh = h >> 2;
    const float* cache_k = F.in[2]; const float* cache_v = F.in[3];
    float* sk = F.out + O_SK; float* sv = F.out + O_SV;
    const float sink2 = F.in[8][h] * LOG2E;
    const bf16* qrow = Q + (size_t)(MP + sb) * QD + h * 64;
    float sc[2];
#pragma unroll
    for (int half = 0; half < 2; ++half) {
        const int j = lane + 64 * half;
        const float* kr = (j < 127) ? cache_k + ((size_t)(sb * 128 + j + 1) * 4 + kvh) * 64 : sk + ((size_t)(sb * 128 + 127) * 4 + kvh) * 64;
        float* kd = sk + ((size_t)(sb * 128 + j) * 4 + kvh) * 64;
        float dot = 0.f;
#pragma unroll
        for (int d4 = 0; d4 < 16; ++d4) {
            const f32x4 kv = *(const f32x4*)(kr + d4 * 4);
            const v2u qq = *(const v2u*)(qrow + d4 * 4);
            dot += kv.x * bf_lo(qq.x) + kv.y * bf_hi(qq.x) + kv.z * bf_lo(qq.y) + kv.w * bf_hi(qq.y);
            if (docopy && j < 127) *(f32x4*)(kd + d4 * 4) = kv;
        }
        sc[half] = dot * C2;
    }
    const float mx = fmaxf(sink2, wave_max(fmaxf(sc[0], sc[1])));
    const float p0 = __builtin_amdgcn_exp2f(sc[0] - mx), p1 = __builtin_amdgcn_exp2f(sc[1] - mx);
    const float l = wave_sum(p0 + p1) + __builtin_amdgcn_exp2f(sink2 - mx);
    float o = 0.f;
#pragma unroll 16
    for (int j = 0; j < 128; ++j) {
        const float pj = __shfl(j < 64 ? p0 : p1, j & 63);
        const float* vr = (j < 127) ? cache_v + ((size_t)(sb * 128 + j + 1) * 4 + kvh) * 64 : sv + ((size_t)(sb * 128 + 127) * 4 + kvh) * 64;
        const float v = vr[lane];
        o += pj * v;
        if (docopy && j < 127) (sv + ((size_t)(sb * 128 + j) * 4 + kvh) * 64)[lane] = v;
    }
    const float r = o / l;
    const float r2 = __shfl_down(r, 1);
    if ((lane & 1) == 0) *(unsigned*)(mix + (size_t)(MP + sb) * DM + h * 64 + lane) = pk2(r, r2);
}

__device__ __forceinline__ void sample_conv_unit(int sb, const Frame& F, bf16* mix) {
    const int lane = F.lane;
    const float* cc = F.in[4] + (size_t)sb * 30 * CCH; const float* cw = F.in[9];
    float* sc = F.out + O_SC + (size_t)sb * 30 * CCH;
    f32x4 y[4];
    const int cl = lane * 4;
#pragma unroll
    for (int k = 0; k < 4; ++k) { const f32x4 uv = *(const f32x4*)(cc + cl + 256 * k); y[k] = *(const f32x4*)(F.in[10] + cl + 256 * k) + *(const f32x4*)(cw + cl + 256 * k) * uv; }
#pragma unroll 4
    for (int j = 1; j < 30; ++j) {
#pragma unroll
        for (int k = 0; k < 4; ++k) { const int c = cl + 256 * k; const f32x4 uv = *(const f32x4*)(cc + (size_t)j * CCH + c); y[k] += *(const f32x4*)(cw + (size_t)j * CCH + c) * uv; *(f32x4*)(sc + (size_t)(j - 1) * CCH + c) = uv; }
    }
#pragma unroll
    for (int k = 0; k < 4; ++k) { const int c = cl + 256 * k; y[k] += *(const f32x4*)(cw + (size_t)30 * CCH + c) * *(const f32x4*)(sc + (size_t)29 * CCH + c); }
    float s = 0.f;
#pragma unroll
    for (int k = 0; k < 4; ++k) s += (y[k].x + y[k].y) + (y[k].z + y[k].w);
    const float mu = wave_sum(s) * (1.0f / CCH);
    float q = 0.f;
#pragma unroll
    for (int k = 0; k < 4; ++k) { y[k] = y[k] - mu; q += (y[k].x * y[k].x + y[k].y * y[k].y) + (y[k].z * y[k].z + y[k].w * y[k].w); }
    const float rstd = 1.0f / sqrtf(wave_sum(q) * (1.0f / CCH) + EPS);
#pragma unroll
    for (int k = 0; k < 4; ++k) {
        const int c = lane * 4 + 256 * k;
        const f32x4 g = *(const f32x4*)(F.in[11] + c), bb = *(const f32x4*)(F.in[12] + c);
        f32x4 yn = y[k] * rstd * g + bb;
#pragma unroll
        for (int e = 0; e < 4; ++e) yn[e] = yn[e] * __builtin_amdgcn_rcpf(1.0f + __expf(-yn[e]));
        *(v2u*)(mix + (size_t)(MP + sb) * DM + QD + c) = (v2u){pk2(yn.x, yn.y), pk2(yn.z, yn.w)};
    }
}

typedef float f32x2 __attribute__((ext_vector_type(2)));
__device__ __forceinline__ void conv_prompt_unit(int b, int t0, const Frame& F, const bf16* U, bf16* mix, const f32x2 (&w)[CONVW], f32x2 cb, f32x2 lg, f32x2 lb) {
    const int c0 = 2 * F.tid;
    LAS float* red = (LAS float*)(F.lds + RING_OFF);
    const bf16* ub = U + (size_t)b * SEQ * CCH + c0;
    f32x2 win[38];
#pragma unroll
    for (int i = 0; i < 30; ++i) { const int t = t0 - 30 + i; const unsigned x = (t >= 0) ? *(const unsigned*)(ub + (size_t)t * CCH) : 0u; win[i] = (f32x2){bf_lo(x), bf_hi(x)}; }
    unsigned nx[8];
#pragma unroll
    for (int r = 0; r < 8; ++r) nx[r] = *(const unsigned*)(ub + (size_t)(t0 + r) * CCH);
    const int lane = F.lane;
    for (int bt = 0; bt < 16; ++bt) {
        const int tb = t0 + bt * 8;
#pragma unroll
        for (int r = 0; r < 8; ++r) win[30 + r] = (f32x2){bf_lo(nx[r]), bf_hi(nx[r])};
        if (bt + 1 < 16) {
#pragma unroll
            for (int r = 0; r < 8; ++r) nx[r] = *(const unsigned*)(ub + (size_t)(tb + 8 + r) * CCH);
        }
        f32x2 y[8]; float st[16];
#pragma unroll
        for (int r = 0; r < 8; ++r) {
            f32x2 a = cb;
#pragma unroll
            for (int j = 0; j < CONVW; ++j) a += w[j] * win[r + j];
            y[r] = a; const f32x2 a2 = a * a; st[2 * r] = a.x + a.y; st[2 * r + 1] = a2.x + a2.y;
        }
        { const bool b5 = lane & 32, b4 = lane & 16, b3 = lane & 8, b2 = lane & 4;
          float s8[8], s4[4], s2[2], s1;
#pragma unroll
          for (int k = 0; k < 8; ++k) { const float snd = b5 ? st[k] : st[k + 8], kp = b5 ? st[k + 8] : st[k]; s8[k] = kp + __shfl_xor(snd, 32); }
#pragma unroll
          for (int k = 0; k < 4; ++k) { const float snd = b4 ? s8[k] : s8[k + 4], kp = b4 ? s8[k + 4] : s8[k]; s4[k] = kp + __shfl_xor(snd, 16); }
#pragma unroll
          for (int k = 0; k < 2; ++k) { const float snd = b3 ? s4[k] : s4[k + 2], kp = b3 ? s4[k + 2] : s4[k]; s2[k] = kp + __shfl_xor(snd, 8); }
          { const float snd = b2 ? s2[0] : s2[1], kp = b2 ? s2[1] : s2[0]; s1 = kp + __shfl_xor(snd, 4); }
          s1 += __shfl_xor(s1, 2); s1 += __shfl_xor(s1, 1);
          LAS float* rb = red + (bt & 1) * 128;
          if ((lane & 3) == 0) rb[F.wave * 16 + (lane >> 2)] = s1;
          asm volatile("s_waitcnt lgkmcnt(0)" ::: "memory"); __builtin_amdgcn_s_barrier(); asm volatile("" ::: "memory");
          f32x4 t4[4];
#pragma unroll
          for (int k = 0; k < 4; ++k) t4[k] = *(const LAS f32x4*)(rb + 4 * k);
#pragma unroll
          for (int wv = 1; wv < 8; ++wv)
#pragma unroll
              for (int k = 0; k < 4; ++k) t4[k] += *(const LAS f32x4*)(rb + wv * 16 + 4 * k);
#pragma unroll
          for (int k = 0; k < 16; ++k) st[k] = t4[k >> 2][k & 3];
        }
#pragma unroll
        for (int r = 0; r < 8; ++r) {
            const float mu = st[2 * r] * (1.0f / CCH), var = fmaxf(st[2 * r + 1] * (1.0f / CCH) - mu * mu, 0.f), rstd = __builtin_amdgcn_rsqf(var + EPS);
            f32x2 a = (y[r] - mu) * (lg * rstd) + lb;
            a.x = a.x * __builtin_amdgcn_rcpf(1.0f + __expf(-a.x)); a.y = a.y * __builtin_amdgcn_rcpf(1.0f + __expf(-a.y));
            *(unsigned*)(mix + ((size_t)b * SEQ + tb + r) * DM + QD + c0) = pk2(a.x, a.y);
        }
#pragma unroll
        for (int i = 0; i < 30; ++i) win[i] = win[i + 8];
    }
    asm volatile("s_waitcnt lgkmcnt(0)" ::: "memory"); __builtin_amdgcn_s_barrier(); asm volatile("" ::: "memory");
}

__device__ __forceinline__ void p2_mixers(Frame& F, int mask) {
    const bf16* Q = (const bf16*)(F.ws + WS_Q); const bf16* Kb = (const bf16*)(F.ws + WS_K); const bf16* Vp = (const bf16*)(F.ws + WS_V); const bf16* U = (const bf16*)(F.ws + WS_U);
    bf16* mix = (bf16*)(F.ws + WS_A);
    if (mask & 1) {
        const int c0 = 2 * F.tid;
        f32x2 w[CONVW];
#pragma unroll
        for (int j = 0; j < CONVW; ++j) w[j] = *(const f32x2*)(F.in[9] + (size_t)j * CCH + c0);
        const f32x2 cb = *(const f32x2*)(F.in[10] + c0), lg = *(const f32x2*)(F.in[11] + c0), lb = *(const f32x2*)(F.in[12] + c0);
        for (int unit = blockIdx.x; unit < NBATCH * 16; unit += F.G) conv_prompt_unit(unit >> 4, (unit & 15) * 128, F, U, mix, w, cb, lg, lb);
    }
    const int gw = blockIdx.x * NWAVES + F.wave, NGW = F.G * NWAVES;
    if (mask & 2) for (int au = gw; au < NBATCH * 4 * 64 * 4; au += NGW) {
        const int g = au & 3, qb = (au >> 2) & 63, kvh = (au >> 8) & 3, b = au >> 10, h = kvh * 4 + g;
        attn_wave_unit(b, h, qb, Q, Kb, Vp, mix, F.in[8][h] * LOG2E, F.lane);
    }
    if (mask & 4) for (int su = gw; su < MS * 16; su += NGW) { const int sb = su >> 4, h = su & 15; sample_attn_unit(sb, h, F, Q, mix, (h & 3) == 0); }
    if ((mask & 8) && F.wave == 7) for (int su = blockIdx.x; su < MS; su += F.G) sample_conv_unit(su, F, mix);
}


#define MFMA16(a, b, c) __builtin_amdgcn_mfma_f32_16x16x32_bf16((a), (b), (c), 0, 0, 0)
template <int NT, int BS>
__device__ __forceinline__ void skinny_wave(const bf16* A, int lda, const bf16* Bt, int ldb, const int (&brow)[NT], int k0, int klen, int R0, int lane, f32x4 (&acc)[NT]) {
    const int fr = lane & 15, fq = lane >> 4;
    const bf16* ap = A + (size_t)(R0 + fr) * lda + k0 + fq * 8;
    const bf16* bp[NT];
#pragma unroll
    for (int t = 0; t < NT; ++t) { bp[t] = Bt + (size_t)(brow[t] + fr) * ldb + k0 + fq * 8; acc[t] = (f32x4){0.f, 0.f, 0.f, 0.f}; }
    bf16x8 a[2][BS], bb[2][NT][BS];
#define SK_LOAD(buf, kk) do { _Pragma("unroll") for (int i_ = 0; i_ < BS; ++i_) { a[buf][i_] = *(const bf16x8*)(ap + (kk) + 32 * i_); \
        _Pragma("unroll") for (int t_ = 0; t_ < NT; ++t_) bb[buf][t_][i_] = *(const bf16x8*)(bp[t_] + (kk) + 32 * i_); } } while (0)
#define SK_MMA(buf) do { _Pragma("unroll") for (int i_ = 0; i_ < BS; ++i_) _Pragma("unroll") for (int t_ = 0; t_ < NT; ++t_) acc[t_] = MFMA16(a[buf][i_], bb[buf][t_][i_], acc[t_]); } while (0)
    const int bstep = 32 * BS, nb = klen / bstep;
    SK_LOAD(0, 0);
    for (int kb = 0; kb < nb; kb += 2) {
        SK_LOAD(1, (kb + 1) * bstep); SCHED_BAR(); SK_MMA(0); SCHED_BAR();
        const int nk = (kb + 2 < nb) ? (kb + 2) * bstep : 0;
        SK_LOAD(0, nk); SCHED_BAR(); SK_MMA(1); SCHED_BAR();
    }
#undef SK_LOAD
#undef SK_MMA
}
__device__ __forceinline__ bf16 f2bf1(float v) { return (bf16)(pk2(v, 0.f) & 0xffffu); }

__device__ __forceinline__ void p1_sample(Frame& F) {
    const bf16* XN = (const bf16*)(F.ws + WS_A); const bf16* Win = (const bf16*)(F.ws + WS_WIN);
    const float* bperm = (const float*)(F.ws + WS_BPERM); const float* ropeS = (const float*)(F.ws + WS_ROPE) + (size_t)SEQ * 16;
    bf16* Q = (bf16*)(F.ws + WS_Q);
    const int lane = F.lane, fr = lane & 15, fq = lane >> 4, R0 = MP + 16 * F.wave;
    for (int job = blockIdx.x; job < 160; job += F.G) {
        if (job < 96) {
            const int zc0 = (job < 80) ? job * 16 : 1280 + (job - 80) * 16;
            const int brow[1] = {zc0}; f32x4 acc[1];
            skinny_wave<1, 8>(XN, DM, Win, DM, brow, 0, DM, R0, lane, acc);
            const float bias = bperm[zc0 + fr];
            const bool rope = (job < 80) && ((job & 3) == 0);
            const float rc = ropeS[fr & 7], rs = ropeS[8 + (fr & 7)];
#pragma unroll
            for (int i = 0; i < 4; ++i) {
                const int sb = 16 * F.wave + 4 * fq + i;
                float v = acc[0][i] + bias;
                if (rope) { const float p = __shfl_xor(v, 8); v = (fr < 8) ? v * rc - p * rs : v * rc + p * rs; }
                if (job < 64) Q[(size_t)(MP + sb) * QD + zc0 + fr] = f2bf1(v);
                else if (job < 80) F.out[O_SK + ((size_t)sb * 128 + 127) * KVD + (zc0 - 1024) + fr] = v;
                else F.out[O_SV + ((size_t)sb * 128 + 127) * KVD + (zc0 - 1280) + fr] = v;
            }
        } else {
            const int c0 = (job - 96) * 16, r0 = 1536 + (c0 >> 7) * 256 + (c0 & 127);
            const int brow[2] = {r0, r0 + 128}; f32x4 acc[2];
            skinny_wave<2, 4>(XN, DM, Win, DM, brow, 0, DM, R0, lane, acc);
            const float bv = bperm[r0 + fr], bg = bperm[r0 + 128 + fr];
#pragma unroll
            for (int i = 0; i < 4; ++i) {
                const int sb = 16 * F.wave + 4 * fq + i;
                const float val = acc[0][i] + bv, gate = acc[1][i] + bg;
                F.out[O_SC + ((size_t)sb * 30 + 29) * CCH + c0 + fr] = val * __builtin_amdgcn_rcpf(1.0f + __expf(-gate));
            }
        }
    }
}
__device__ __forceinline__ void p3_sample(Frame& F) {
    const bf16* mix = (const bf16*)(F.ws + WS_A); const bf16* Wout = (const bf16*)(F.ws + WS_WOUT); bf16* HB = (bf16*)(F.ws + WS_HB);
    float* rowss = (float*)(F.ws + WS_ROWSS);
    const int lane = F.lane, fr = lane & 15, fq = lane >> 4, R0 = MP + 16 * F.wave;
    for (int job = blockIdx.x; job < 128; job += F.G) {
        const int brow[1] = {job * 16}; f32x4 acc[1];
        skinny_wave<1, 8>(mix, DM, Wout, DM, brow, 0, DM, R0, lane, acc);
        const int col = job * 16 + fr; const float bias = F.in[14][col];
#pragma unroll
        for (int i = 0; i < 4; ++i) {
            const int sb = 16 * F.wave + 4 * fq + i;
            const float v = acc[0][i] + bias + F.in[1][(size_t)sb * DM + col];
            HB[(size_t)(MP + sb) * DM + col] = f2bf1(v);
            float ss = v * v; ss += __shfl_xor(ss, 1); ss += __shfl_xor(ss, 2); ss += __shfl_xor(ss, 4); ss += __shfl_xor(ss, 8);
            if (fr == 0) unsafeAtomicAdd(rowss + MP + sb, ss);
        }
    }
}
__device__ __forceinline__ void p4_sample(Frame& F) {
    const bf16* HB = (const bf16*)(F.ws + WS_HB); const bf16* Wup = (const bf16*)(F.ws + WS_WUP); bf16* ACT = (bf16*)(F.ws + WS_ACT);
    const float* rowss = (const float*)(F.ws + WS_ROWSS);
    const int lane = F.lane, fr = lane & 15, fq = lane >> 4, R0 = MP + 16 * F.wave;
    for (int job = blockIdx.x; job < 256; job += F.G) {
        const int brow[2] = {job * 32, job * 32 + 16}; f32x4 acc[2];
        skinny_wave<2, 4>(HB, DM, Wup, DM, brow, 0, DM, R0, lane, acc);
#pragma unroll
        for (int i = 0; i < 4; ++i) {
            const int sb = 16 * F.wave + 4 * fq + i;
            const float rr = 1.0f / (rowss[MP + sb] * (1.0f / DM) + EPS);
#pragma unroll
            for (int t = 0; t < 2; ++t) { const float a = fmaxf(acc[t][i], 0.f); ACT[(size_t)(MP + sb) * DFF + brow[t] + fr] = f2bf1(a * a * rr); }
        }
    }
}
__device__ __forceinline__ void p5_sample(Frame& F) {
    const bf16* ACT = (const bf16*)(F.ws + WS_ACT); const bf16* Wdn = (const bf16*)(F.ws + WS_WDN); float* part = (float*)(F.ws + WS_PART);
    const int lane = F.lane, fr = lane & 15, fq = lane >> 4, R0 = MP + 16 * F.wave;
    for (int job = blockIdx.x; job < 256; job += F.G) {
        const int ct = job & 127, kh = job >> 7;
        const int brow[1] = {ct * 16}; f32x4 acc[1];
        skinny_wave<1, 8>(ACT, DFF, Wdn, DFF, brow, kh * (DFF / 2), DFF / 2, R0, lane, acc);
#pragma unroll
        for (int i = 0; i < 4; ++i) { const int sb = 16 * F.wave + 4 * fq + i; part[((size_t)kh * MS + sb) * DM + ct * 16 + fr] = acc[0][i]; }
    }
}

__device__ __forceinline__ void p6_final(Frame& F) {
    const int gw = blockIdx.x * NWAVES + F.wave, NGW = F.G * NWAVES;
    const float* rs2 = (const float*)(F.ws + WS_ROWSS2); const float* gf = F.in[18];
    const bf16* YB = (const bf16*)(F.ws + WS_A); const bf16* HB = (const bf16*)(F.ws + WS_HB);
    {
        f32x4 g[8];
#pragma unroll
        for (int j = 0; j < 4; ++j) { g[2 * j] = *(const f32x4*)(gf + (j * 64 + F.lane) * 8); g[2 * j + 1] = *(const f32x4*)(gf + (j * 64 + F.lane) * 8 + 4); }
        for (int m = gw; m < MP; m += NGW) {
            const float r = 1.0f / sqrtf(rs2[m] * (1.0f / DM) + EPS);
            const v4u* yr = (const v4u*)(YB + (size_t)m * DM) + F.lane;
            float* orow = F.out + (size_t)m * DM + F.lane * 8;
            v4u yv[4];
#pragma unroll
            for (int j = 0; j < 4; ++j) yv[j] = yr[64 * j];
#pragma unroll
            for (int j = 0; j < 4; ++j) {
                const f32x4 a = (f32x4){bf_lo(yv[j].x), bf_hi(yv[j].x), bf_lo(yv[j].y), bf_hi(yv[j].y)}, c = (f32x4){bf_lo(yv[j].z), bf_hi(yv[j].z), bf_lo(yv[j].w), bf_hi(yv[j].w)};
                *(f32x4*)(orow + j * 512) = a * r * g[2 * j]; *(f32x4*)(orow + j * 512 + 4) = c * r * g[2 * j + 1];
            }
        }
    }
    for (int sb = NGW - 1 - gw; sb < MS; sb += NGW) {
        f32x4* xr = (f32x4*)(F.out + (size_t)(MP + sb) * DM) + F.lane;
        const v2u* hr = (const v2u*)(HB + (size_t)(MP + sb) * DM) + F.lane;
        const f32x4* p0 = (const f32x4*)((const float*)(F.ws + WS_PART) + (size_t)sb * DM) + F.lane;
        const f32x4* p1 = (const f32x4*)((const float*)(F.ws + WS_PART) + (size_t)(MS + sb) * DM) + F.lane;
        f32x4 v[8]; float s = 0.f;
#pragma unroll
        for (int j = 0; j < 8; ++j) { const v2u hh = hr[64 * j]; v[j] = (f32x4){bf_lo(hh.x), bf_hi(hh.x), bf_lo(hh.y), bf_hi(hh.y)} + p0[64 * j] + p1[64 * j]; s += (v[j].x * v[j].x + v[j].y * v[j].y) + (v[j].z * v[j].z + v[j].w * v[j].w); }
        const float r = 1.0f / sqrtf(wave_sum(s) * (1.0f / DM) + EPS);
#pragma unroll
        for (int j = 0; j < 8; ++j) xr[64 * j] = v[j] * r * *((const f32x4*)gf + F.lane + 64 * j);
    }
}

constexpr int NPHASE = 7;
struct Args { const float* in[19]; float* out; unsigned char* ws; int ph_lo, ph_hi, p2mask, pad; };
__global__ void __launch_bounds__(NWAVES * 64, 2) mk_fwd(Args args) {
    extern __shared__ __attribute__((aligned(16))) unsigned char lds[];
    Frame F;
    F.lds = (LAS unsigned char*)lds;
    F.tid = threadIdx.x; F.lane = F.tid & 63; F.wave = __builtin_amdgcn_readfirstlane(F.tid >> 6); F.G = gridDim.x;
#pragma unroll
    for (int i = 0; i < 19; ++i) F.in[i] = args.in[i];
    F.out = args.out; F.ws = args.ws;
    const int lo = args.ph_lo, hi = args.ph_hi;
#define IN(k) (lo <= (k) && (k) < hi)
#define SEAM(k) do { if (IN(k) && IN((k) + 1)) { cg::this_grid().sync(); } } while (0)
    bf16* Win = (bf16*)(F.ws + WS_WIN); bf16* Wout = (bf16*)(F.ws + WS_WOUT); bf16* Wup = (bf16*)(F.ws + WS_WUP); bf16* Wdn = (bf16*)(F.ws + WS_WDN);
    bf16* XA = (bf16*)(F.ws + WS_A); bf16* HB = (bf16*)(F.ws + WS_HB); bf16* ACT = (bf16*)(F.ws + WS_ACT);
    float* rowss = (float*)(F.ws + WS_ROWSS); float* rowss2 = (float*)(F.ws + WS_ROWSS2);

    if (IN(0)) { p0_prologue(F); }
    SEAM(0);
    if (IN(1)) {
        pg8::Gemm g{XA, Win, MP, IN_DIM, DM}; pg8::StaticOrder S; S.init(MP, IN_DIM, F.G, (int)blockIdx.x);
        pg8::EpiIn E{(bf16*)(F.ws + WS_Q), (bf16*)(F.ws + WS_K), (bf16*)(F.ws + WS_V), (bf16*)(F.ws + WS_U), (const float*)(F.ws + WS_BPERM), (const float*)(F.ws + WS_ROPE), F.out};
        pg8::gemm_phase<pg8::EpiIn, pg8::StaticOrder, true, true>(F.lds + RING_OFF, g, S, E);
        p1_sample(F);
    }
    SEAM(1);
    if (IN(2)) { p2_mixers(F, args.p2mask); }
    SEAM(2);
    if (IN(3)) {
        pg8::Gemm g{XA, Wout, MP, DM, DM}; pg8::StaticOrder S; S.init(MP, DM, F.G, (int)blockIdx.x);
        pg8::EpiOut E{F.in[0], F.in[14], HB, rowss};
        pg8::gemm_phase<pg8::EpiOut, pg8::StaticOrder, true, true>(F.lds + RING_OFF, g, S, E);
        p3_sample(F);
    }
    SEAM(3);
    if (IN(4)) {
        pg8::Gemm g{HB, Wup, MP, DFF, DM}; pg8::StaticOrder S; S.init(MP, DFF, F.G, (int)blockIdx.x);
        pg8::EpiUp E{ACT, rowss};
        pg8::gemm_phase<pg8::EpiUp, pg8::StaticOrder, true, true>(F.lds + RING_OFF, g, S, E);
        p4_sample(F);
    }
    SEAM(4);
    if (IN(5)) {
        pg8::Gemm g{ACT, Wdn, MP, DM, DFF}; pg8::StaticOrder S; S.init(MP, DM, F.G, (int)blockIdx.x);
        pg8::EpiDown E{HB, XA, rowss2};
        pg8::gemm_phase<pg8::EpiDown, pg8::StaticOrder, true, true>(F.lds + RING_OFF, g, S, E);
        p5_sample(F);
    }
    SEAM(5);
    if (IN(6)) { p6_final(F); }
#undef IN
#undef SEAM
}

extern "C" void kernel_launch(void* const* d_in, const int* in_sizes, int n_in, void* d_out, int out_size, void* d_ws, size_t ws_size, hipStream_t stream) {
    static int grid = 0;
    if (grid == 0) {
        int dev = 0, cus = 0, per_cu = 0;
        (void)hipGetDevice(&dev);
        (void)hipDeviceGetAttribute(&cus, hipDeviceAttributeMultiprocessorCount, dev);
        if (hipFuncSetAttribute((const void*)mk_fwd, hipFuncAttributeMaxDynamicSharedMemorySize, LDS_BYTES) != hipSuccess) fprintf(stderr, "kernel_launch: hipFuncSetAttribute failed\n");
        if (hipOccupancyMaxActiveBlocksPerMultiprocessor(&per_cu, (const void*)mk_fwd, NWAVES * 64, LDS_BYTES) != hipSuccess || per_cu < 1) per_cu = 1;
        (void)hipGetLastError();
        if (cus <= 0) cus = 256;
        grid = cus * per_cu;
        if (n_in != 19 || ws_size < 1024 * MiB) fprintf(stderr, "kernel_launch: unexpected n_in %d / ws_size %zu\n", n_in, ws_size);
    }
    Args a{};
    for (int i = 0; i < 19; ++i) a.in[i] = (const float*)d_in[i];
    a.out = (float*)d_out; a.ws = (unsigned char*)d_ws; a.p2mask = 15;
#if MK_LAUNCHES == 1
    a.ph_lo = 0; a.ph_hi = NPHASE;
    void* params[] = {&a};
    hipError_t e = hipLaunchCooperativeKernel((const void*)mk_fwd, dim3(grid), dim3(NWAVES * 64), params, LDS_BYTES, stream);
    if (e != hipSuccess) fprintf(stderr, "cooperative launch failed: %s (grid %d)\n", hipGetErrorString(e), grid);
#else
    for (int p = 0; p < NPHASE; ++p) {
        a.ph_lo = p; a.ph_hi = p + 1;
        hipLaunchKernelGGL(mk_fwd, dim3(grid), dim3(NWAVES * 64), LDS_BYTES, stream, a);
        if (p == 2 && PROBE_REP > 0) { a.p2mask = PROBE_REP; hipLaunchKernelGGL(mk_fwd, dim3(grid), dim3(NWAVES * 64), LDS_BYTES, stream, a); a.p2mask = 15; }
    }
#endif
}
```

```cpp
#include <hip/hip_runtime.h>
#include <hip/hip_cooperative_groups.h>
#include <cstdio>
#include <cstdint>
namespace cg = cooperative_groups;

#ifndef PROBE_REP
#define PROBE_REP -1
#endif
#ifndef MK_LAUNCHES
#define MK_LAUNCHES 1
#endif

constexpr int DM = 2048, NBATCH = 16, SEQ = 2048, MP = NBATCH * SEQ, MS = 128, MR = MP + MS, RPAD = 33024;
constexpr int QD = 1024, KVD = 256, CCH = 1024, IN_DIM = 3584, DFF = 8192, CONVW = 31;
constexpr float EPS = 1e-5f;
constexpr float C2 = 0.125f * 1.4426950408889634f;
constexpr float LOG2E = 1.4426950408889634f;
constexpr size_t O_Y = 0, O_PK = 67371008, O_PV = 67895296, O_PC = 68419584, O_SK = 68911104, O_SV = 73105408, O_SC = 77299712;
constexpr size_t MiB = 1u << 20;
constexpr size_t WS_WIN = 0, WS_WOUT = 14 * MiB, WS_WUP = 22 * MiB, WS_WDN = 54 * MiB;
constexpr size_t WS_ROPE = 86 * MiB, WS_BPERM = 86 * MiB + 256 * 1024, WS_ROWSS = 86 * MiB + 512 * 1024, WS_ROWSS2 = 86 * MiB + 768 * 1024;
constexpr size_t WS_PART = 87 * MiB;
constexpr size_t WS_A = 90 * MiB;
constexpr size_t WS_Q = 219 * MiB;
constexpr size_t WS_K = WS_Q + (size_t)RPAD * 1024 * 2;
constexpr size_t WS_V = WS_K + (size_t)RPAD * 256 * 2;
constexpr size_t WS_U = WS_V + (size_t)RPAD * 256 * 2;
constexpr size_t WS_HB = WS_Q;
constexpr size_t WS_ACT = 381 * MiB;
static_assert(WS_U + (size_t)RPAD * 1024 * 2 <= WS_ACT && WS_HB + (size_t)RPAD * 2048 * 2 <= WS_ACT, "ws map");
static_assert(WS_ACT + (size_t)RPAD * 8192 * 2 <= 1024 * MiB, "ws map end");

namespace pg8 {
#define PG8_LAS __attribute__((address_space(3)))
typedef unsigned short bf16_t;
typedef short bf16x8 __attribute__((ext_vector_type(8)));
typedef float f32x4 __attribute__((ext_vector_type(4)));
typedef unsigned u32x4 __attribute__((ext_vector_type(4)));
constexpr int BM = 256, BK = 64, HALF = 128, HTB = HALF * BK * 2  , STAGE_BYTES = 8 * HTB, NXCD = 8, WGM = 8;

__host__ __device__ __forceinline__ int lds_byte(int r, int c) { const int st = (r >> 4) * 2 + (c >> 5), rr = r & 15, cc = c & 31, ob = rr * 64 + cc * 2; return st * 1024 + (ob ^ (((ob >> 9) & 1) << 5)); }
__host__ __device__ __forceinline__ void stage_rc(int b, int& R, int& C) { const int st = b / 1024, sb = b % 1024, swz = sb ^ (((sb >> 9) & 1) << 5); R = (st >> 1) * 16 + swz / 64; C = (st & 1) * 32 + (swz % 64) / 2; }
__host__ __device__ __forceinline__ int perm32(int rho) { const int n = rho >> 4, i = rho & 15; return 8 * (i >> 2) + 4 * n + (i & 3); }

struct Unit { int pm, pn; };
struct Gemm { const bf16_t* A; const bf16_t* Bt; int M, N, K; };

struct StaticOrder {
    int nM, nN, nwg, G, c;
    __host__ __device__ void init(int M, int N, int G_, int c_) { nM = M / BM; nN = N / BM; nwg = nM * nN; G = G_; c = c_; }
    __host__ __device__ bool next(int i, Unit& u) const {
        const long L = (long)i * G + c; if (L >= nwg) return false;
        int wgid = (int)L; { const int q = nwg / NXCD, r = nwg % NXCD, xcd = wgid % NXCD, off = wgid / NXCD; wgid = (xcd < r ? xcd * (q + 1) : r * (q + 1) + (xcd - r) * q) + off; }
        const int nig = WGM * nN, gid = wgid / nig, fm = gid * WGM, gsz = (nM - fm) < WGM ? (nM - fm) : WGM;
        u.pm = fm + ((wgid % nig) % gsz); u.pn = (wgid % nig) / gsz; return true;
    }
    __device__ __forceinline__ void a_ready(const Unit&) const {}
    __device__ __forceinline__ void done(const Unit&) const {}
};

typedef float f32x2_t __attribute__((ext_vector_type(2)));
typedef __bf16 bf16x2_t __attribute__((ext_vector_type(2)));
__device__ __forceinline__ unsigned pk2(float lo, float hi) { f32x2_t v = {lo, hi}; bf16x2_t b = __builtin_convertvector(v, bf16x2_t); return __builtin_bit_cast(unsigned, b); }
__device__ __forceinline__ u32x4 pk8(const f32x4& a, const f32x4& b) { u32x4 w; w.x = pk2(a[0], a[1]); w.y = pk2(a[2], a[3]); w.z = pk2(b[0], b[1]); w.w = pk2(b[2], b[3]); return w; }
__device__ __forceinline__ float sumsq8(const f32x4& a, const f32x4& b) { return ((a[0] * a[0] + a[1] * a[1]) + (a[2] * a[2] + a[3] * a[3])) + ((b[0] * b[0] + b[1] * b[1]) + (b[2] * b[2] + b[3] * b[3])); }

struct EpiIn {
    static constexpr bool PERM = true, AFTER_DRAIN = false;
    bf16_t *Q, *Kb, *Vp, *U; const float* bias; const float* rope; float* out;
    __device__ __forceinline__ void operator()(const f32x4 (&acc)[2][2][4][2], const Unit& u, int wr, int wc, int fr, int fq) const {
        const int pn = u.pn, colw = wc * 32 + 8 * fq;
        f32x4 bv[2][2];
#pragma unroll
        for (int bj = 0; bj < 2; ++bj)
#pragma unroll
            for (int n = 0; n < 2; ++n) bv[bj][n] = *(const f32x4*)(bias + pn * 256 + bj * HALF + colw + 4 * n);
        const bool dorope = (pn < 5) && ((wc & 1) == 0);
#pragma unroll
        for (int ai = 0; ai < 2; ++ai)
#pragma unroll
            for (int m = 0; m < 4; ++m) {
                const int row = u.pm * BM + ai * HALF + wr * 64 + m * 16 + fr;
                const bool isP = row < MP, isS = (!isP) && row < MR;
                const int t = row & (SEQ - 1), b = row >> 11;
                if (pn >= 6) {
                    const int c = (pn - 6) * 128 + colw;
                    f32x4 o[2];
#pragma unroll
                    for (int n = 0; n < 2; ++n) {
                        const f32x4 val = acc[ai][0][m][n] + bv[0][n], gate = acc[ai][1][m][n] + bv[1][n];
#pragma unroll
                        for (int e = 0; e < 4; ++e) o[n][e] = val[e] * __builtin_amdgcn_rcpf(1.0f + __expf(-gate[e]));
                    }
                    *(u32x4*)(U + (size_t)row * CCH + c) = pk8(o[0], o[1]);
                    float* dst = nullptr;
                    if (isP && t >= SEQ - 30) dst = out + O_PC + ((size_t)(b * 30 + t - (SEQ - 30))) * CCH + c;
                    if (isS) dst = out + O_SC + ((size_t)((row - MP) * 30 + 29)) * CCH + c;
                    if (dst) { *(f32x4*)dst = o[0]; *(f32x4*)(dst + 4) = o[1]; }
                } else {
                    f32x4 c0, c1, s0, s1;
                    if (dorope) { const float* rp = rope + (size_t)(isP ? t : SEQ) * 16; c0 = *(const f32x4*)rp; c1 = *(const f32x4*)(rp + 4); s0 = *(const f32x4*)(rp + 8); s1 = *(const f32x4*)(rp + 12);
                        if (fq == 0) { s0 = -s0; s1 = -s1; } }
#pragma unroll
                    for (int bj = 0; bj < 2; ++bj) {
                        f32x4 v0 = acc[ai][bj][m][0] + bv[bj][0], v1 = acc[ai][bj][m][1] + bv[bj][1];
                        if (dorope) {
                            f32x4 p0, p1;
#pragma unroll
                            for (int e = 0; e < 4; ++e) { p0[e] = __shfl_xor(v0[e], 16); p1[e] = __shfl_xor(v1[e], 16); }
                            if (fq < 2) { v0 = v0 * c0 + p0 * s0; v1 = v1 * c1 + p1 * s1; }
                        }
                        const int col = bj * HALF + colw;
                        const u32x4 w = pk8(v0, v1);
                        if (pn < 4) {
                            const int qc = pn * 256 + col, hq = qc >> 6, d = qc & 63;
                            *(u32x4*)(Q + (size_t)(b * 16 + hq) * (SEQ * 64) + (size_t)(((((t >> 5) * 4 + (d >> 4)) * 2 + ((d >> 3) & 1)) * 32 + (t & 31)) * 8)) = w; }
                        else {
                            if (pn == 4) {
                                const int kvh = col >> 6, d = col & 63;
                                *(u32x4*)(Kb + (size_t)(b * 4 + kvh) * (SEQ * 64) + (size_t)(((((t >> 5) * 4 + (d >> 4)) * 2 + ((d >> 3) & 1)) * 32 + (t & 31)) * 8)) = w; }
                            else if (isP) {
                                const int kvh = col >> 6, d = col & 63, kb = t >> 5, kap = t & 31;
                                const int i = kap & 3, hh = (kap >> 2) & 1, j = kap >> 3, s = j >> 1, e0 = 4 * (j & 1) + i;
                                bf16_t* vp = Vp + (size_t)(b * 4 + kvh) * (SEQ * 64) + (size_t)((((kb * 2 + (d >> 5)) * 2 + s) * 2 + hh) * 256) + (d & 31) * 8 + e0;
                                vp[0] = (bf16_t)(w.x & 0xffffu); vp[8] = (bf16_t)(w.x >> 16); vp[16] = (bf16_t)(w.y & 0xffffu); vp[24] = (bf16_t)(w.y >> 16);
                                vp[32] = (bf16_t)(w.z & 0xffffu); vp[40] = (bf16_t)(w.z >> 16); vp[48] = (bf16_t)(w.w & 0xffffu); vp[56] = (bf16_t)(w.w >> 16);
                            }
                            float* dst = nullptr;
                            if (isP && t >= SEQ - 128) dst = out + (pn == 4 ? O_PK : O_PV) + ((size_t)(b * 128 + t - (SEQ - 128))) * KVD + col;
                            if (isS) dst = out + (pn == 4 ? O_SK : O_SV) + ((size_t)((row - MP) * 128 + 127)) * KVD + col;
                            if (dst) { *(f32x4*)dst = v0; *(f32x4*)(dst + 4) = v1; }
                        }
                    }
                }
            }
    }
};

struct EpiOut {
    static constexpr bool PERM = true, AFTER_DRAIN = false;
    const float *xp, *bias; bf16_t* HB; float* rowss;
    __device__ __forceinline__ void operator()(const f32x4 (&acc)[2][2][4][2], const Unit& u, int wr, int wc, int fr, int fq) const {
        const int colb = u.pn * BM + wc * 32 + 8 * fq;
        f32x4 bv[2][2];
#pragma unroll
        for (int bj = 0; bj < 2; ++bj)
#pragma unroll
            for (int n = 0; n < 2; ++n) bv[bj][n] = *(const f32x4*)(bias + colb + bj * HALF + 4 * n);
#pragma unroll
        for (int ai = 0; ai < 2; ++ai)
#pragma unroll
            for (int m = 0; m < 4; ++m) {
                const int row = u.pm * BM + ai * HALF + wr * 64 + m * 16 + fr;
                const float* xr = xp + (size_t)row * DM;
                float ss = 0.f;
#pragma unroll
                for (int bj = 0; bj < 2; ++bj) {
                    const int col = colb + bj * HALF;
                    const f32x4 v0 = acc[ai][bj][m][0] + bv[bj][0] + *(const f32x4*)(xr + col), v1 = acc[ai][bj][m][1] + bv[bj][1] + *(const f32x4*)(xr + col + 4);
                    *(u32x4*)(HB + (size_t)row * DM + col) = pk8(v0, v1);
                    ss += sumsq8(v0, v1);
                }
                ss += __shfl_xor(ss, 16); ss += __shfl_xor(ss, 32);
                if (fq == 0) unsafeAtomicAdd(rowss + row, ss);
            }
    }
};

struct EpiUp {
    static constexpr bool PERM = true, AFTER_DRAIN = false;
    bf16_t* ACT; const float* rowss;
    __device__ __forceinline__ void operator()(const f32x4 (&acc)[2][2][4][2], const Unit& u, int wr, int wc, int fr, int fq) const {
        const int colb = u.pn * BM + wc * 32 + 8 * fq;
#pragma unroll
        for (int ai = 0; ai < 2; ++ai)
#pragma unroll
            for (int m = 0; m < 4; ++m) {
                const int row = u.pm * BM + ai * HALF + wr * 64 + m * 16 + fr;
                const float rr = 1.0f / (rowss[row] * (1.0f / DM) + EPS);
#pragma unroll
                for (int bj = 0; bj < 2; ++bj) {
                    f32x4 v0 = acc[ai][bj][m][0], v1 = acc[ai][bj][m][1];
#pragma unroll
                    for (int e = 0; e < 4; ++e) { const float a = fmaxf(v0[e], 0.f), c = fmaxf(v1[e], 0.f); v0[e] = a * a * rr; v1[e] = c * c * rr; }
                    *(u32x4*)(ACT + (size_t)row * DFF + colb + bj * HALF) = pk8(v0, v1);
                }
            }
    }
};

__device__ __forceinline__ f32x4 bfx4_lo(const u32x4& w) { return (f32x4){__uint_as_float(w.x << 16), __uint_as_float(w.x & 0xffff0000u), __uint_as_float(w.y << 16), __uint_as_float(w.y & 0xffff0000u)}; }
__device__ __forceinline__ f32x4 bfx4_hi(const u32x4& w) { return (f32x4){__uint_as_float(w.z << 16), __uint_as_float(w.z & 0xffff0000u), __uint_as_float(w.w << 16), __uint_as_float(w.w & 0xffff0000u)}; }
struct EpiDown {
    static constexpr bool PERM = true, AFTER_DRAIN = false;
    const bf16_t* HB; bf16_t* YB; float* rowss;
    __device__ __forceinline__ void operator()(const f32x4 (&acc)[2][2][4][2], const Unit& u, int wr, int wc, int fr, int fq) const {
        const int colb = u.pn * BM + wc * 32 + 8 * fq;
#pragma unroll
        for (int ai = 0; ai < 2; ++ai)
#pragma unroll
            for (int m = 0; m < 4; ++m) {
                const int row = u.pm * BM + ai * HALF + wr * 64 + m * 16 + fr;
                float ss = 0.f;
#pragma unroll
                for (int bj = 0; bj < 2; ++bj) {
                    const size_t off = (size_t)row * DM + colb + bj * HALF;
                    const u32x4 hw = *(const u32x4*)(HB + off);
                    const f32x4 v0 = acc[ai][bj][m][0] + bfx4_lo(hw), v1 = acc[ai][bj][m][1] + bfx4_hi(hw);
                    *(u32x4*)(YB + off) = pk8(v0, v1);
                    ss += sumsq8(v0, v1);
                }
                ss += __shfl_xor(ss, 16); ss += __shfl_xor(ss, 32);
                if (fq == 0) unsafeAtomicAdd(rowss + row, ss);
            }
    }
};

template <class Epi, class Sched, bool ALIGN_EPI = false, bool SP2 = false>
__device__ __forceinline__ void gemm_phase(PG8_LAS unsigned char* lds, const Gemm g, const Sched& S, const Epi& E) {
    const int tid = threadIdx.x, wid = __builtin_amdgcn_readfirstlane(tid >> 6), lane = tid & 63, wr = wid >> 2, wc = wid & 3, fr = lane & 15, fq = lane >> 4;
    const int K = g.K, nt = K / BK;
    unsigned voffA[2], voffB[2];
#pragma unroll
    for (int i = 0; i < 2; ++i) { int R, C; stage_rc(tid * 16 + i * 8192, R, C); const int Rb = Epi::PERM ? ((R & ~31) + perm32(R & 31)) : R;
        voffA[i] = (unsigned)(R * K + C) * 2u; voffB[i] = (unsigned)(Rb * K + C) * 2u; }
    const size_t kstep = (size_t)(BK * 2);
    const size_t hstep = (size_t)HALF * K * 2;
    const size_t tstep = 2 * hstep;
    const unsigned ldsw = (unsigned)wid * 1024u;
    const int aoff = lds_byte(wr * 64 + fr, fq * 8), boff = lds_byte(wc * 32 + fr, fq * 8);
#define PG8_SA(b, h) (((b) * 2 + (h)) * HTB)
#define PG8_SB(b, h) ((4 + (b) * 2 + (h)) * HTB)
#define PG8_STAGE(bufoff, gbase, voff) do { _Pragma("unroll") for (int _i = 0; _i < 2; ++_i) \
        __builtin_amdgcn_global_load_lds((const unsigned*)((const char*)(gbase) + (voff)[_i]), (PG8_LAS unsigned*)(lds + (bufoff) + ldsw + _i * 8192), 16, 0, 0); } while (0)
#define PG8_LDA(dst, b, h) do { _Pragma("unroll") for (int m = 0; m < 4; ++m) _Pragma("unroll") for (int k = 0; k < 2; ++k) dst[m][k] = *(const PG8_LAS bf16x8*)(lds + PG8_SA(b, h) + aoff + m * 2048 + k * 1024); } while (0)
#define PG8_LDB(dst, b, h) do { _Pragma("unroll") for (int n = 0; n < 2; ++n) _Pragma("unroll") for (int k = 0; k < 2; ++k) dst[n][k] = *(const PG8_LAS bf16x8*)(lds + PG8_SB(b, h) + boff + n * 2048 + k * 1024); } while (0)
#define PG8_MMA(ai, bj, At, Bt) do { __builtin_amdgcn_s_setprio(1); _Pragma("unroll") for (int m = 0; m < 4; ++m) _Pragma("unroll") for (int n = 0; n < 2; ++n) _Pragma("unroll") for (int k = 0; k < 2; ++k) \
        acc[ai][bj][m][n] = __builtin_amdgcn_mfma_f32_16x16x32_bf16(Bt[n][k], At[m][k], acc[ai][bj][m][n], 0, 0, 0); __builtin_amdgcn_s_setprio(0); } while (0)
#define PG8_WAIT_V(n) asm volatile("s_waitcnt vmcnt(" #n ")" ::: "memory")
#define PG8_WAIT_L(n) asm volatile("s_waitcnt lgkmcnt(" #n ")" ::: "memory")
#define PG8_BAR __builtin_amdgcn_s_barrier()
#define PG8_SCHED __builtin_amdgcn_sched_barrier(0)
    Unit cur, nxt; int ui = 0;
    if (!S.next(0, cur)) return;
    f32x4 acc[2][2][4][2];
#pragma unroll
    for (int a = 0; a < 2; ++a)
#pragma unroll
        for (int b = 0; b < 2; ++b)
#pragma unroll
            for (int m = 0; m < 4; ++m)
#pragma unroll
                for (int n = 0; n < 2; ++n) acc[a][b][m][n] = (f32x4){0.f, 0.f, 0.f, 0.f};
    bf16x8 At[4][2], B0[2][2], B1[2][2];
    const char* cA = (const char*)g.A + (size_t)cur.pm * tstep; const char* cB = (const char*)g.Bt + (size_t)cur.pn * tstep;
    S.a_ready(cur);
    if constexpr (SP2) {
        PG8_STAGE(PG8_SB(0, 0), cB, voffB); PG8_STAGE(PG8_SB(0, 1), cB + hstep, voffB); PG8_STAGE(PG8_SA(0, 0), cA, voffA); PG8_STAGE(PG8_SA(0, 1), cA + hstep, voffA);
        if (wr == 1) PG8_BAR;
        PG8_WAIT_V(2); PG8_BAR;
        PG8_STAGE(PG8_SB(1, 0), cB + kstep, voffB); PG8_STAGE(PG8_SA(1, 0), cA + kstep, voffA); PG8_STAGE(PG8_SB(1, 1), cB + hstep + kstep, voffB);
        PG8_WAIT_V(6); PG8_BAR;
    } else {
        PG8_STAGE(PG8_SB(0, 0), cB, voffB); PG8_STAGE(PG8_SA(0, 0), cA, voffA); PG8_STAGE(PG8_SB(0, 1), cB + hstep, voffB); PG8_STAGE(PG8_SA(0, 1), cA + hstep, voffA);
        if (wr == 1) PG8_BAR;
        PG8_WAIT_V(4); PG8_BAR;
        PG8_STAGE(PG8_SB(1, 0), cB + kstep, voffB); PG8_STAGE(PG8_SA(1, 0), cA + kstep, voffA); PG8_STAGE(PG8_SB(1, 1), cB + hstep + kstep, voffB);
        PG8_WAIT_V(6); PG8_BAR;
    }
    for (;;) {
        const bool has_next = S.next(ui + 1, nxt);
        const char* nA = has_next ? (const char*)g.A + (size_t)nxt.pm * tstep : cA; const char* nB = has_next ? (const char*)g.Bt + (size_t)nxt.pn * tstep : cB;
        for (int t = 0; t < nt; t += 2) {
            const bool last = (t == nt - 2);
            const char* a1 = cA + (size_t)(t + 1) * kstep;
            const char* a2 = last ? nA : cA + (size_t)(t + 2) * kstep; const char* b2 = last ? nB : cB + (size_t)(t + 2) * kstep;
            const char* a3 = a2 + kstep; const char* b3 = b2 + kstep;
            if (last && has_next) S.a_ready(nxt);
            if constexpr (SP2) {
            PG8_LDB(B0, 0, 0); PG8_LDB(B1, 0, 1); PG8_SCHED; PG8_LDA(At, 0, 0); PG8_STAGE(PG8_SA(1, 1), a1 + hstep, voffA);
            PG8_WAIT_V(8); PG8_WAIT_L(0); PG8_BAR; PG8_MMA(0, 0, At, B0); PG8_MMA(0, 1, At, B1); PG8_BAR; PG8_SCHED;
            PG8_LDA(At, 0, 1); PG8_STAGE(PG8_SB(0, 0), b2, voffB); PG8_STAGE(PG8_SB(0, 1), b2 + hstep, voffB); PG8_STAGE(PG8_SA(0, 0), a2, voffA);
            PG8_WAIT_V(8); PG8_WAIT_L(0); PG8_BAR; PG8_MMA(1, 0, At, B0); PG8_MMA(1, 1, At, B1); PG8_BAR; PG8_SCHED;
            PG8_LDB(B0, 1, 0); PG8_LDB(B1, 1, 1); PG8_SCHED; PG8_LDA(At, 1, 0); PG8_STAGE(PG8_SA(0, 1), a2 + hstep, voffA);
            PG8_WAIT_V(8); PG8_WAIT_L(0); PG8_BAR; PG8_MMA(0, 0, At, B0); PG8_MMA(0, 1, At, B1); PG8_BAR; PG8_SCHED;
            PG8_LDA(At, 1, 1); PG8_STAGE(PG8_SB(1, 0), b3, voffB); PG8_STAGE(PG8_SB(1, 1), b3 + hstep, voffB); PG8_STAGE(PG8_SA(1, 0), a3, voffA);
            PG8_WAIT_V(8); PG8_WAIT_L(0); PG8_BAR; PG8_MMA(1, 0, At, B0); PG8_MMA(1, 1, At, B1); PG8_BAR; PG8_SCHED;
            } else {
            PG8_LDB(B0, 0, 0); PG8_SCHED; PG8_LDA(At, 0, 0); PG8_STAGE(PG8_SA(1, 1), a1 + hstep, voffA);
            PG8_WAIT_L(8); PG8_BAR; PG8_WAIT_L(0); PG8_MMA(0, 0, At, B0); PG8_BAR; PG8_SCHED;
            PG8_LDB(B1, 0, 1); PG8_STAGE(PG8_SB(0, 0), b2, voffB);
            PG8_BAR; PG8_WAIT_L(0); PG8_MMA(0, 1, At, B1); PG8_BAR;
            PG8_LDA(At, 0, 1); PG8_STAGE(PG8_SA(0, 0), a2, voffA);
            PG8_BAR; PG8_WAIT_L(0); PG8_MMA(1, 0, At, B0); PG8_BAR; PG8_SCHED;
            PG8_STAGE(PG8_SB(0, 1), b2 + hstep, voffB);
            PG8_WAIT_V(6); PG8_BAR; PG8_MMA(1, 1, At, B1); PG8_BAR;
            PG8_LDB(B0, 1, 0); PG8_SCHED; PG8_LDA(At, 1, 0); PG8_STAGE(PG8_SA(0, 1), a2 + hstep, voffA);
            PG8_WAIT_L(8); PG8_BAR; PG8_WAIT_L(0); PG8_MMA(0, 0, At, B0); PG8_BAR; PG8_SCHED;
            PG8_LDB(B1, 1, 1); PG8_STAGE(PG8_SB(1, 0), b3, voffB);
            PG8_BAR; PG8_WAIT_L(0); PG8_MMA(0, 1, At, B1); PG8_BAR;
            PG8_LDA(At, 1, 1); PG8_STAGE(PG8_SA(1, 0), a3, voffA);
            PG8_BAR; PG8_WAIT_L(0); PG8_MMA(1, 0, At, B0); PG8_BAR; PG8_SCHED;
            PG8_STAGE(PG8_SB(1, 1), b3 + hstep, voffB);
            PG8_WAIT_V(6); PG8_BAR; PG8_MMA(1, 1, At, B1); PG8_BAR;
            }
        }
        if constexpr (ALIGN_EPI) { if (wr == 0) PG8_BAR; }
        if constexpr (!Epi::AFTER_DRAIN) { E(acc, cur, wr, wc, fr, fq); S.done(cur); }
        if (!has_next) break;
#pragma unroll
        for (int a = 0; a < 2; ++a)
#pragma unroll
            for (int b = 0; b < 2; ++b)
#pragma unroll
                for (int m = 0; m < 4; ++m)
#pragma unroll
                    for (int n = 0; n < 2; ++n) acc[a][b][m][n] = (f32x4){0.f, 0.f, 0.f, 0.f};
        cur = nxt; cA = nA; cB = nB; ++ui;
        if constexpr (ALIGN_EPI) { if (wr == 1) PG8_BAR; }
    }
    PG8_WAIT_V(0);
    if constexpr (!ALIGN_EPI) { if (wr == 0) PG8_BAR; }
    PG8_BAR;
    if constexpr (Epi::AFTER_DRAIN) { E.fused(acc, cur, wr, wc, fr, fq, lds, wid, lane); S.done(cur); }
#undef PG8_SA
#undef PG8_SB
#undef PG8_STAGE
#undef PG8_LDA
#undef PG8_LDB
#undef PG8_MMA
#undef PG8_WAIT_V
#undef PG8_WAIT_L
#undef PG8_BAR
#undef PG8_SCHED
}
}

constexpr int RING_OFF = 0, RING_BYTES = 131072;
constexpr int LDS_BYTES = 147456;
constexpr int NWAVES = 8;
#define LAS __attribute__((address_space(3)))
typedef unsigned short bf16;
typedef unsigned v4u __attribute__((ext_vector_type(4)));
typedef unsigned v2u __attribute__((ext_vector_type(2)));
typedef float f32x4 __attribute__((ext_vector_type(4)));
typedef float f32x16 __attribute__((ext_vector_type(16)));
typedef short bf16x8 __attribute__((ext_vector_type(8)));
#define LDS_WAIT() asm volatile("s_waitcnt lgkmcnt(0)" ::: "memory")
using pg8::pk2;

__device__ __forceinline__ float wave_sum(float v) {
#pragma unroll
    for (int o = 1; o < 64; o <<= 1) v += __shfl_xor(v, o);
    return v;
}
__device__ __forceinline__ float wave_max(float v) {
#pragma unroll
    for (int o = 1; o < 64; o <<= 1) v = fmaxf(v, __shfl_xor(v, o));
    return v;
}
__device__ __forceinline__ float bf_lo(unsigned x) { return __uint_as_float(x << 16); }
__device__ __forceinline__ float bf_hi(unsigned x) { return __uint_as_float(x & 0xffff0000u); }

struct Frame {
    LAS unsigned char* lds;
    int tid, lane, wave, G;
    const float* in[19]; float* out; unsigned char* ws;
};

__device__ __forceinline__ void p0_transpose_item(const float* W, int K, int N, bf16* WT, int k0, int n0, int drow0, const float* kscale, LAS float* scr, int lane) {
    float tv[32];
#pragma unroll
    for (int i = 0; i < 32; ++i) { const int kk = 2 * i + (lane >> 5); tv[i] = W[(size_t)(k0 + kk) * N + n0 + (lane & 31)]; }
    if (kscale) {
#pragma unroll
        for (int i = 0; i < 32; ++i) tv[i] *= kscale[k0 + 2 * i + (lane >> 5)];
    }
#pragma unroll
    for (int i = 0; i < 32; ++i) scr[(2 * i + (lane >> 5)) * 33 + (lane & 31)] = tv[i];
    LDS_WAIT(); asm volatile("" ::: "memory");
    const int c = lane & 7;
#pragma unroll
    for (int j = 0; j < 4; ++j) { const int n = (lane >> 3) + 8 * j; const LAS float* s = scr + (8 * c) * 33 + n;
        v4u o; o.x = pk2(s[0 * 33], s[1 * 33]); o.y = pk2(s[2 * 33], s[3 * 33]); o.z = pk2(s[4 * 33], s[5 * 33]); o.w = pk2(s[6 * 33], s[7 * 33]);
        *(v4u*)(WT + (size_t)(drow0 + n) * K + k0 + 8 * c) = o; }
    LDS_WAIT(); asm volatile("" ::: "memory");
}
__device__ __forceinline__ int inproj_row(int n) {
    if (n < 1536) return n;
    if (n < 2560) { const int c = n - 1536; return 1536 + (c >> 7) * 256 + (c & 127); }
    const int c = n - 2560; return 1536 + (c >> 7) * 256 + 128 + (c & 127);
}
__device__ __forceinline__ void sincos_acc(float ang, float& c, float& s) {
    const double x = (double)ang;
    const double n = rint(x * 0.63661977236758134308);
    double r = fma(-n, 1.57079632679489655800, x); r = fma(-n, 6.12323399573676603587e-17, r);
    const int q = ((int)n) & 3;
    const double r2 = r * r;
    const double sp = r * (1.0 + r2 * (-1.0 / 6 + r2 * (1.0 / 120 + r2 * (-1.0 / 5040 + r2 * (1.0 / 362880 + r2 * (-1.0 / 39916800 + r2 * (1.0 / 6227020800.0)))))));
    const double cp = 1.0 + r2 * (-0.5 + r2 * (1.0 / 24 + r2 * (-1.0 / 720 + r2 * (1.0 / 40320 + r2 * (-1.0 / 3628800 + r2 * (1.0 / 479001600 + r2 * (-1.0 / 87178291200.0)))))));
    const double ss = (q == 0) ? sp : (q == 1) ? cp : (q == 2) ? -sp : -cp;
    const double cc = (q == 0) ? cp : (q == 1) ? -sp : (q == 2) ? -cp : sp;
    c = (float)cc; s = (float)ss;
}
__device__ __forceinline__ void p0_prologue(Frame& F) {
    LAS float* scr = (LAS float*)(F.lds + RING_OFF + F.wave * 16384);
    const int gw = blockIdx.x * NWAVES + F.wave, NGW = F.G * NWAVES;
    const int gt = blockIdx.x * (NWAVES * 64) + F.tid, NGT = F.G * NWAVES * 64;
    bf16* Win = (bf16*)(F.ws + WS_WIN); bf16* Wout = (bf16*)(F.ws + WS_WOUT); bf16* Wup = (bf16*)(F.ws + WS_WUP); bf16* Wdn = (bf16*)(F.ws + WS_WDN);
    { float* rope = (float*)(F.ws + WS_ROPE);
      for (int e = gt; e < (SEQ + 1) * 8; e += NGT) { const int p = e >> 3, i = e & 7; const float pos = (p < SEQ) ? (float)p : 16384.0f;
          const float invf[8] = {1.0f, 0.19392274474868576f, 0.03760603093086393f, 0.007292664737217109f, 0.001414213562373095f, 0.0002742481756762073f, 5.318295896944988e-05f, 1.031338537721246e-05f};
          float fsel = invf[0];
#pragma unroll
          for (int k = 1; k < 8; ++k) fsel = (i == k) ? invf[k] : fsel;
          const float ang = pos * fsel; float c, s; sincos_acc(ang, c, s); rope[p * 16 + i] = c; rope[p * 16 + 8 + i] = s; }
      float* bperm = (float*)(F.ws + WS_BPERM); const float* b_in = F.in[7];
      for (int n = gt; n < IN_DIM; n += NGT) bperm[inproj_row(n)] = b_in[n];
      float* rs = (float*)(F.ws + WS_ROWSS); float* rs2 = (float*)(F.ws + WS_ROWSS2);
      for (int r = gt; r < RPAD; r += NGT) { rs[r] = 0.f; rs2[r] = 0.f; } }
    constexpr int I_IN = (DM / 64) * (IN_DIM / 32), I_OUT = (DM / 64) * (DM / 32), I_UP = (DM / 64) * (DFF / 32), I_DN = (DFF / 64) * (DM / 32);
    constexpr int NITEMS = I_IN + I_OUT + I_UP + I_DN;
    for (int it = gw; it < NITEMS; it += NGW) {
        int r = it;
        if (r < I_IN) { const int nblk = IN_DIM / 32, kb = r / nblk, nb = r % nblk; p0_transpose_item(F.in[6], DM, IN_DIM, Win, 64 * kb, 32 * nb, inproj_row(32 * nb), nullptr, scr, F.lane); continue; } r -= I_IN;
        if (r < I_OUT) { const int nblk = DM / 32, kb = r / nblk, nb = r % nblk; p0_transpose_item(F.in[13], DM, DM, Wout, 64 * kb, 32 * nb, 32 * nb, nullptr, scr, F.lane); continue; } r -= I_OUT;
        if (r < I_UP) { const int nblk = DFF / 32, kb = r / nblk, nb = r % nblk; p0_transpose_item(F.in[16], DM, DFF, Wup, 64 * kb, 32 * nb, 32 * nb, F.in[15], scr, F.lane); continue; } r -= I_UP;
        { const int nblk = DM / 32, kb = r / nblk, nb = r % nblk; p0_transpose_item(F.in[17], DFF, DM, Wdn, 64 * kb, 32 * nb, 32 * nb, nullptr, scr, F.lane); }
    }
    bf16* XN = (bf16*)(F.ws + WS_A); const float* g1 = F.in[5];
    for (int m0 = gw; m0 < MR; m0 += 2 * NGW) {
        const int m1 = m0 + NGW; const bool has1 = m1 < MR; const int m1c = has1 ? m1 : m0;
        const f32x4* xa = (const f32x4*)(m0 < MP ? F.in[0] + (size_t)m0 * DM : F.in[1] + (size_t)(m0 - MP) * DM) + F.lane;
        const f32x4* xb = (const f32x4*)(m1c < MP ? F.in[0] + (size_t)m1c * DM : F.in[1] + (size_t)(m1c - MP) * DM) + F.lane;
        f32x4 va[8], vb[8]; float sa = 0.f, sb = 0.f;
#pragma unroll
        for (int j = 0; j < 8; ++j) { va[j] = xa[64 * j]; vb[j] = xb[64 * j]; }
#pragma unroll
        for (int j = 0; j < 8; ++j) { sa += (va[j].x * va[j].x + va[j].y * va[j].y) + (va[j].z * va[j].z + va[j].w * va[j].w); sb += (vb[j].x * vb[j].x + vb[j].y * vb[j].y) + (vb[j].z * vb[j].z + vb[j].w * vb[j].w); }
        const float ra = 1.0f / sqrtf(wave_sum(sa) * (1.0f / DM) + EPS), rb = 1.0f / sqrtf(wave_sum(sb) * (1.0f / DM) + EPS);
        v2u* oa = (v2u*)(XN + (size_t)m0 * DM) + F.lane; v2u* ob = (v2u*)(XN + (size_t)m1c * DM) + F.lane;
#pragma unroll
        for (int j = 0; j < 8; ++j) { const f32x4 g = *((const f32x4*)g1 + F.lane + 64 * j);
            oa[64 * j] = (v2u){pk2(va[j].x * ra * g.x, va[j].y * ra * g.y), pk2(va[j].z * ra * g.z, va[j].w * ra * g.w)};
            if (has1) ob[64 * j] = (v2u){pk2(vb[j].x * rb * g.x, vb[j].y * rb * g.y), pk2(vb[j].z * rb * g.z, vb[j].w * rb * g.w)}; }
    }
}

#define MFMA32(a, b, c) __builtin_amdgcn_mfma_f32_32x32x16_bf16((a), (b), (c), 0, 0, 0)
__device__ __forceinline__ int crow(int r, int hi) { return (r & 3) + 8 * (r >> 2) + 4 * hi; }

#define SCHED_BAR() __builtin_amdgcn_sched_barrier(0)
constexpr int ATT_BUF = 49152, ATT_VOFF = 24576;
__device__ __forceinline__ void attn_dma_unit(int u, const bf16* Kp, const bf16* Vp, LAS unsigned char* buf, int wave, int lane) {
    const int pair = u & 31, kvh = (u >> 5) & 3, b = u >> 7, kblk0 = 2 * pair - 4;
    const size_t plane = (size_t)(b * 4 + kvh) * (SEQ * 64);
#pragma unroll
    for (int i = 0; i < 6; ++i) {
        const int p = wave + 8 * i;
        const int isv = p >= 24, pp = isv ? p - 24 : p;
        int kb = kblk0 + (pp >> 2); kb = kb > 0 ? kb : 0;
        const bf16* g = (isv ? Vp : Kp) + plane + (size_t)kb * 2048 + (pp & 3) * 512 + lane * 8;
        __builtin_amdgcn_global_load_lds((const unsigned*)g, (LAS unsigned*)(buf + (isv ? ATT_VOFF : 0) + pp * 1024), 16, 0, 0);
    }
}
__device__ __forceinline__ void attn_phase(Frame& F, const bf16* Q, const bf16* Kp, const bf16* Vp, bf16* mix) {
    const int lane = F.lane, wave = F.wave, r32 = lane & 31, hi = lane >> 5, hl = wave & 3, qsel = wave >> 2;
    const int NU = NBATCH * 4 * 32;
    int u = blockIdx.x;
    if (u >= NU) return;
    LAS unsigned char* lbase = F.lds + RING_OFF;
    attn_dma_unit(u, Kp, Vp, lbase, wave, lane);
    bf16x8 qf[4];
    { const int pair = u & 31, kvh = (u >> 5) & 3, b = u >> 7; const bf16* qp = Q + (size_t)(b * 16 + kvh * 4 + hl) * (SEQ * 64) + (size_t)(2 * pair + qsel) * 2048 + lane * 8;
#pragma unroll
      for (int d0 = 0; d0 < 4; ++d0) qf[d0] = *(const bf16x8*)(qp + d0 * 512); }
    v4u held[4]; bf16* hptr = nullptr;
    LAS unsigned char* wst = lbase + 2 * ATT_BUF + wave * 4352;
    LAS float* wsf = (LAS float*)(wst + 4096);
    int it = 0;
    for (; u < NU; u += F.G, ++it) {
        const int pair = u & 31, kvh = (u >> 5) & 3, b = u >> 7, h = kvh * 4 + hl, qb = 2 * pair + qsel, kb0 = qb - 4;
        asm volatile("s_waitcnt vmcnt(0)" ::: "memory"); __builtin_amdgcn_s_barrier(); asm volatile("" ::: "memory");
        if (hptr) {
#pragma unroll
            for (int i = 0; i < 4; ++i) *(v4u*)(hptr + (size_t)(i * 8) * DM) = held[i];
        }
        const int un = u + F.G;
        LAS unsigned char* buf = lbase + (it & 1) * ATT_BUF;
        if (un < NU) attn_dma_unit(un, Kp, Vp, lbase + ((it + 1) & 1) * ATT_BUF, wave, lane);
        const float sink2 = F.in[8][h] * LOG2E;
        f32x16 S[5];
#pragma unroll
        for (int jb = 0; jb < 5; ++jb) {
            const LAS unsigned char* kp = buf + (qsel + jb) * 4096 + lane * 16;
            f32x16 a;
#pragma unroll
            for (int r = 0; r < 16; ++r) a[r] = 0.f;
#pragma unroll
            for (int d0 = 0; d0 < 4; ++d0) a = MFMA32(*(const LAS bf16x8*)(kp + d0 * 1024), qf[d0], a);
            S[jb] = a;
        }
        SCHED_BAR();
        if (un < NU) { const int pn = un & 31, kn = (un >> 5) & 3, bn = un >> 7; const bf16* qp = Q + (size_t)(bn * 16 + kn * 4 + hl) * (SEQ * 64) + (size_t)(2 * pn + qsel) * 2048 + lane * 8;
#pragma unroll
            for (int d0 = 0; d0 < 4; ++d0) qf[d0] = *(const bf16x8*)(qp + d0 * 512); }
        float mx = sink2;
#pragma unroll
        for (int jb = 0; jb < 5; ++jb) {
            const bool blk_ok = (kb0 + jb) >= 0;
#pragma unroll
            for (int r = 0; r < 16; ++r) {
                float x = S[jb][r] * C2;
                bool ok = blk_ok;
                if (jb == 0) ok = ok && (crow(r, hi) > r32);
                if (jb == 4) ok = ok && (crow(r, hi) <= r32);
                x = ok ? x : -INFINITY;
                S[jb][r] = x; mx = fmaxf(mx, x);
            }
        }
        mx = fmaxf(mx, __shfl_xor(mx, 32));
        float l = 0.f;
#pragma unroll
        for (int jb = 0; jb < 5; ++jb)
#pragma unroll
            for (int r = 0; r < 16; ++r) { const float pv = __builtin_amdgcn_exp2f(S[jb][r] - mx); S[jb][r] = pv; l += pv; }
        l += __shfl_xor(l, 32);
        l += __builtin_amdgcn_exp2f(sink2 - mx);
        f32x16 o[2];
#pragma unroll
        for (int r = 0; r < 16; ++r) { o[0][r] = 0.f; o[1][r] = 0.f; }
#pragma unroll
        for (int jb = 0; jb < 5; ++jb) {
            const LAS unsigned char* vp = buf + ATT_VOFF + (qsel + jb) * 4096 + lane * 16;
#pragma unroll
            for (int sx = 0; sx < 2; ++sx) {
                v4u pw; pw.x = pk2(S[jb][8 * sx + 0], S[jb][8 * sx + 1]); pw.y = pk2(S[jb][8 * sx + 2], S[jb][8 * sx + 3]); pw.z = pk2(S[jb][8 * sx + 4], S[jb][8 * sx + 5]); pw.w = pk2(S[jb][8 * sx + 6], S[jb][8 * sx + 7]);
                const bf16x8 pf = __builtin_bit_cast(bf16x8, pw);
#pragma unroll
                for (int db = 0; db < 2; ++db) o[db] = MFMA32(pf, *(const LAS bf16x8*)(vp + (db * 2 + sx) * 1024), o[db]);
            }
        }
        if (hi == 0) wsf[r32] = 1.0f / l;
        asm volatile("s_waitcnt lgkmcnt(0)" ::: "memory");
#pragma unroll
        for (int r = 0; r < 16; ++r) { const float li = wsf[crow(r, hi)]; const int q = crow(r, hi);
#pragma unroll
            for (int db = 0; db < 2; ++db) ((LAS bf16*)wst)[q * 64 + db * 32 + r32] = (bf16)(pk2(o[db][r] * li, 0.f) & 0xffffu); }
        asm volatile("s_waitcnt lgkmcnt(0)" ::: "memory");
#pragma unroll
        for (int i = 0; i < 4; ++i) held[i] = *(const LAS v4u*)(wst + (i * 8 + (lane >> 3)) * 128 + (lane & 7) * 16);
        hptr = mix + ((size_t)b * SEQ + qb * 32 + (lane >> 3)) * DM + h * 64 + (lane & 7) * 8;
    }
    if (hptr) {
#pragma unroll
        for (int i = 0; i < 4; ++i) *(v4u*)(hptr + (size_t)(i * 8) * DM) = held[i];
    }
    asm volatile("s_waitcnt vmcnt(0) lgkmcnt(0)" ::: "memory"); __builtin_amdgcn_s_barrier(); asm volatile("" ::: "memory");
}

__device__ __forceinline__ void sample_attn_unit(int sb, int h, const Frame& F, const bf16* Q, bf16* mix, bool docopy) {
    const int lane = F.lane, kvh = h >> 2;
    const float* cache_k = F.in[2]; const float* cache_v = F.in[3];
    float* sk = F.out + O_SK; float* sv = F.out + O_SV;
    const float sink2 = F.in[8][h] * LOG2E;
    const bf16* qrow = Q + (size_t)(MP + sb) * QD + h * 64;
    float sc[2];
#pragma unroll
    for (int half = 0; half < 2; ++half) {
        const int j = lane + 64 * half;
        const float* kr = (j < 127) ? cache_k + ((size_t)(sb * 128 + j + 1) * 4 + kvh) * 64 : sk + ((size_t)(sb * 128 + 127) * 4 + kvh) * 64;
        float* kd = sk + ((size_t)(sb * 128 + j) * 4 + kvh) * 64;
        float dot = 0.f;
#pragma unroll
        for (int d4 = 0; d4 < 16; ++d4) {
            const f32x4 kv = *(const f32x4*)(kr + d4 * 4);
            const v2u qq = *(const v2u*)(qrow + d4 * 4);
            dot += kv.x * bf_lo(qq.x) + kv.y * bf_hi(qq.x) + kv.z * bf_lo(qq.y) + kv.w * bf_hi(qq.y);
            if (docopy && j < 127) *(f32x4*)(kd + d4 * 4) = kv;
        }
        sc[half] = dot * C2;
    }
    const float mx = fmaxf(sink2, wave_max(fmaxf(sc[0], sc[1])));
    const float p0 = __builtin_amdgcn_exp2f(sc[0] - mx), p1 = __builtin_amdgcn_exp2f(sc[1] - mx);
    const float l = wave_sum(p0 + p1) + __builtin_amdgcn_exp2f(sink2 - mx);
    float o = 0.f;
#pragma unroll 16
    for (int j = 0; j < 128; ++j) {
        const float pj = __shfl(j < 64 ? p0 : p1, j & 63);
        const float* vr = (j < 127) ? cache_v + ((size_t)(sb * 128 + j + 1) * 4 + kvh) * 64 : sv + ((size_t)(sb * 128 + 127) * 4 + kvh) * 64;
        const float v = vr[lane];
        o += pj * v;
        if (docopy && j < 127) (sv + ((size_t)(sb * 128 + j) * 4 + kvh) * 64)[lane] = v;
    }
    const float r = o / l;
    const float r2 = __shfl_down(r, 1);
    if ((lane & 1) == 0) *(unsigned*)(mix + (size_t)(MP + sb) * DM + h * 64 + lane) = pk2(r, r2);
}

__device__ __forceinline__ void sample_conv_unit(int sb, const Frame& F, bf16* mix) {
    const int lane = F.lane;
    const float* cc = F.in[4] + (size_t)sb * 30 * CCH; const float* cw = F.in[9];
    float* sc = F.out + O_SC + (size_t)sb * 30 * CCH;
    f32x4 y[4];
    const int cl = lane * 4;
#pragma unroll
    for (int k = 0; k < 4; ++k) { const f32x4 uv = *(const f32x4*)(cc + cl + 256 * k); y[k] = *(const f32x4*)(F.in[10] + cl + 256 * k) + *(const f32x4*)(cw + cl + 256 * k) * uv; }
#pragma unroll 4
    for (int j = 1; j < 30; ++j) {
#pragma unroll
        for (int k = 0; k < 4; ++k) { const int c = cl + 256 * k; const f32x4 uv = *(const f32x4*)(cc + (size_t)j * CCH + c); y[k] += *(const f32x4*)(cw + (size_t)j * CCH + c) * uv; *(f32x4*)(sc + (size_t)(j - 1) * CCH + c) = uv; }
    }
#pragma unroll
    for (int k = 0; k < 4; ++k) { const int c = cl + 256 * k; y[k] += *(const f32x4*)(cw + (size_t)30 * CCH + c) * *(const f32x4*)(sc + (size_t)29 * CCH + c); }
    float s = 0.f;
#pragma unroll
    for (int k = 0; k < 4; ++k) s += (y[k].x + y[k].y) + (y[k].z + y[k].w);
    const float mu = wave_sum(s) * (1.0f / CCH);
    float q = 0.f;
#pragma unroll
    for (int k = 0; k < 4; ++k) { y[k] = y[k] - mu; q += (y[k].x * y[k].x + y[k].y * y[k].y) + (y[k].z * y[k].z + y[k].w * y[k].w); }
    const float rstd = 1.0f / sqrtf(wave_sum(q) * (1.0f / CCH) + EPS);
#pragma unroll
    for (int k = 0; k < 4; ++k) {
        const int c = lane * 4 + 256 * k;
        const f32x4 g = *(const f32x4*)(F.in[11] + c), bb = *(const f32x4*)(F.in[12] + c);
        f32x4 yn = y[k] * rstd * g + bb;
#pragma unroll
        for (int e = 0; e < 4; ++e) yn[e] = yn[e] * __builtin_amdgcn_rcpf(1.0f + __expf(-yn[e]));
        *(v2u*)(mix + (size_t)(MP + sb) * DM + QD + c) = (v2u){pk2(yn.x, yn.y), pk2(yn.z, yn.w)};
    }
}

typedef float f32x2 __attribute__((ext_vector_type(2)));
__device__ __forceinline__ void conv_prompt_unit(int b, int t0, const Frame& F, const bf16* U, bf16* mix, const f32x2 (&w)[CONVW], f32x2 cb, f32x2 lg, f32x2 lb) {
    const int c0 = 2 * F.tid;
    LAS float* red = (LAS float*)(F.lds + RING_OFF);
    const bf16* ub = U + (size_t)b * SEQ * CCH + c0;
    f32x2 win[38];
#pragma unroll
    for (int i = 0; i < 30; ++i) { const int t = t0 - 30 + i; const unsigned x = (t >= 0) ? *(const unsigned*)(ub + (size_t)t * CCH) : 0u; win[i] = (f32x2){bf_lo(x), bf_hi(x)}; }
    unsigned nx[8];
#pragma unroll
    for (int r = 0; r < 8; ++r) nx[r] = *(const unsigned*)(ub + (size_t)(t0 + r) * CCH);
    const int lane = F.lane;
    for (int bt = 0; bt < 16; ++bt) {
        const int tb = t0 + bt * 8;
#pragma unroll
        for (int r = 0; r < 8; ++r) win[30 + r] = (f32x2){bf_lo(nx[r]), bf_hi(nx[r])};
        if (bt + 1 < 16) {
#pragma unroll
            for (int r = 0; r < 8; ++r) nx[r] = *(const unsigned*)(ub + (size_t)(tb + 8 + r) * CCH);
        }
        f32x2 y[8]; float st[16];
#pragma unroll
        for (int r = 0; r < 8; ++r) {
            f32x2 a = cb;
#pragma unroll
            for (int j = 0; j < CONVW; ++j) a += w[j] * win[r + j];
            y[r] = a; const f32x2 a2 = a * a; st[2 * r] = a.x + a.y; st[2 * r + 1] = a2.x + a2.y;
        }
        { const bool b5 = lane & 32, b4 = lane & 16, b3 = lane & 8, b2 = lane & 4;
          float s8[8], s4[4], s2[2], s1;
#pragma unroll
          for (int k = 0; k < 8; ++k) { const float snd = b5 ? st[k] : st[k + 8], kp = b5 ? st[k + 8] : st[k]; s8[k] = kp + __shfl_xor(snd, 32); }
#pragma unroll
          for (int k = 0; k < 4; ++k) { const float snd = b4 ? s8[k] : s8[k + 4], kp = b4 ? s8[k + 4] : s8[k]; s4[k] = kp + __shfl_xor(snd, 16); }
#pragma unroll
          for (int k = 0; k < 2; ++k) { const float snd = b3 ? s4[k] : s4[k + 2], kp = b3 ? s4[k + 2] : s4[k]; s2[k] = kp + __shfl_xor(snd, 8); }
          { const float snd = b2 ? s2[0] : s2[1], kp = b2 ? s2[1] : s2[0]; s1 = kp + __shfl_xor(snd, 4); }
          s1 += __shfl_xor(s1, 2); s1 += __shfl_xor(s1, 1);
          LAS float* rb = red + (bt & 1) * 128;
          if ((lane & 3) == 0) rb[F.wave * 16 + (lane >> 2)] = s1;
          asm volatile("s_waitcnt lgkmcnt(0)" ::: "memory"); __builtin_amdgcn_s_barrier(); asm volatile("" ::: "memory");
          f32x4 t4[4];
#pragma unroll
          for (int k = 0; k < 4; ++k) t4[k] = *(const LAS f32x4*)(rb + 4 * k);
#pragma unroll
          for (int wv = 1; wv < 8; ++wv)
#pragma unroll
              for (int k = 0; k < 4; ++k) t4[k] += *(const LAS f32x4*)(rb + wv * 16 + 4 * k);
#pragma unroll
          for (int k = 0; k < 16; ++k) st[k] = t4[k >> 2][k & 3];
        }
#pragma unroll
        for (int r = 0; r < 8; ++r) {
            const float mu = st[2 * r] * (1.0f / CCH), var = fmaxf(st[2 * r + 1] * (1.0f / CCH) - mu * mu, 0.f), rstd = __builtin_amdgcn_rsqf(var + EPS);
            f32x2 a = (y[r] - mu) * (lg * rstd) + lb;
            a.x = a.x * __builtin_amdgcn_rcpf(1.0f + __expf(-a.x)); a.y = a.y * __builtin_amdgcn_rcpf(1.0f + __expf(-a.y));
            *(unsigned*)(mix + ((size_t)b * SEQ + tb + r) * DM + QD + c0) = pk2(a.x, a.y);
        }
#pragma unroll
        for (int i = 0; i < 30; ++i) win[i] = win[i + 8];
    }
    asm volatile("s_waitcnt lgkmcnt(0)" ::: "memory"); __builtin_amdgcn_s_barrier(); asm volatile("" ::: "memory");
}

__device__ __forceinline__ void p2_mixers(Frame& F, int mask) {
    const bf16* Q = (const bf16*)(F.ws + WS_Q); const bf16* Kb = (const bf16*)(F.ws + WS_K); const bf16* Vp = (const bf16*)(F.ws + WS_V); const bf16* U = (const bf16*)(F.ws + WS_U);
    bf16* mix = (bf16*)(F.ws + WS_A);
    if (mask & 1) {
        const int c0 = 2 * F.tid;
        f32x2 w[CONVW];
#pragma unroll
        for (int j = 0; j < CONVW; ++j) w[j] = *(const f32x2*)(F.in[9] + (size_t)j * CCH + c0);
        const f32x2 cb = *(const f32x2*)(F.in[10] + c0), lg = *(const f32x2*)(F.in[11] + c0), lb = *(const f32x2*)(F.in[12] + c0);
        for (int unit = blockIdx.x; unit < NBATCH * 16; unit += F.G) conv_prompt_unit(unit >> 4, (unit & 15) * 128, F, U, mix, w, cb, lg, lb);
    }
    const int gw = blockIdx.x * NWAVES + F.wave, NGW = F.G * NWAVES;
    if (mask & 2) attn_phase(F, Q, Kb, Vp, mix);
    if (mask & 4) for (int su = gw; su < MS * 16; su += NGW) { const int sb = su >> 4, h = su & 15; sample_attn_unit(sb, h, F, Q, mix, (h & 3) == 0); }
    if ((mask & 8) && F.wave == 7) for (int su = blockIdx.x; su < MS; su += F.G) sample_conv_unit(su, F, mix);
}


#define MFMA16(a, b, c) __builtin_amdgcn_mfma_f32_16x16x32_bf16((a), (b), (c), 0, 0, 0)
template <int NT, int BS>
__device__ __forceinline__ void skinny_wave(const bf16* A, int lda, const bf16* Bt, int ldb, const int (&brow)[NT], int k0, int klen, int R0, int lane, f32x4 (&acc)[NT]) {
    const int fr = lane & 15, fq = lane >> 4;
    const bf16* ap = A + (size_t)(R0 + fr) * lda + k0 + fq * 8;
    const bf16* bp[NT];
#pragma unroll
    for (int t = 0; t < NT; ++t) { bp[t] = Bt + (size_t)(brow[t] + fr) * ldb + k0 + fq * 8; acc[t] = (f32x4){0.f, 0.f, 0.f, 0.f}; }
    bf16x8 a[2][BS], bb[2][NT][BS];
#define SK_LOAD(buf, kk) do { _Pragma("unroll") for (int i_ = 0; i_ < BS; ++i_) { a[buf][i_] = *(const bf16x8*)(ap + (kk) + 32 * i_); \
        _Pragma("unroll") for (int t_ = 0; t_ < NT; ++t_) bb[buf][t_][i_] = *(const bf16x8*)(bp[t_] + (kk) + 32 * i_); } } while (0)
#define SK_MMA(buf) do { _Pragma("unroll") for (int i_ = 0; i_ < BS; ++i_) _Pragma("unroll") for (int t_ = 0; t_ < NT; ++t_) acc[t_] = MFMA16(a[buf][i_], bb[buf][t_][i_], acc[t_]); } while (0)
    const int bstep = 32 * BS, nb = klen / bstep;
    SK_LOAD(0, 0);
    for (int kb = 0; kb < nb; kb += 2) {
        SK_LOAD(1, (kb + 1) * bstep); SCHED_BAR(); SK_MMA(0); SCHED_BAR();
        const int nk = (kb + 2 < nb) ? (kb + 2) * bstep : 0;
        SK_LOAD(0, nk); SCHED_BAR(); SK_MMA(1); SCHED_BAR();
    }
#undef SK_LOAD
#undef SK_MMA
}
__device__ __forceinline__ bf16 f2bf1(float v) { return (bf16)(pk2(v, 0.f) & 0xffffu); }

__device__ __forceinline__ void p1_sample(Frame& F) {
    const bf16* XN = (const bf16*)(F.ws + WS_A); const bf16* Win = (const bf16*)(F.ws + WS_WIN);
    const float* bperm = (const float*)(F.ws + WS_BPERM); const float* ropeS = (const float*)(F.ws + WS_ROPE) + (size_t)SEQ * 16;
    bf16* Q = (bf16*)(F.ws + WS_Q);
    const int lane = F.lane, fr = lane & 15, fq = lane >> 4, R0 = MP + 16 * F.wave;
    for (int job = blockIdx.x; job < 160; job += F.G) {
        if (job < 96) {
            const int zc0 = (job < 80) ? job * 16 : 1280 + (job - 80) * 16;
            const int brow[1] = {zc0}; f32x4 acc[1];
            skinny_wave<1, 8>(XN, DM, Win, DM, brow, 0, DM, R0, lane, acc);
            const float bias = bperm[zc0 + fr];
            const bool rope = (job < 80) && ((job & 3) == 0);
            const float rc = ropeS[fr & 7], rs = ropeS[8 + (fr & 7)];
#pragma unroll
            for (int i = 0; i < 4; ++i) {
                const int sb = 16 * F.wave + 4 * fq + i;
                float v = acc[0][i] + bias;
                if (rope) { const float p = __shfl_xor(v, 8); v = (fr < 8) ? v * rc - p * rs : v * rc + p * rs; }
                if (job < 64) Q[(size_t)(MP + sb) * QD + zc0 + fr] = f2bf1(v);
                else if (job < 80) F.out[O_SK + ((size_t)sb * 128 + 127) * KVD + (zc0 - 1024) + fr] = v;
                else F.out[O_SV + ((size_t)sb * 128 + 127) * KVD + (zc0 - 1280) + fr] = v;
            }
        } else {
            const int c0 = (job - 96) * 16, r0 = 1536 + (c0 >> 7) * 256 + (c0 & 127);
            const int brow[2] = {r0, r0 + 128}; f32x4 acc[2];
            skinny_wave<2, 4>(XN, DM, Win, DM, brow, 0, DM, R0, lane, acc);
            const float bv = bperm[r0 + fr], bg = bperm[r0 + 128 + fr];
#pragma unroll
            for (int i = 0; i < 4; ++i) {
                const int sb = 16 * F.wave + 4 * fq + i;
                const float val = acc[0][i] + bv, gate = acc[1][i] + bg;
                F.out[O_SC + ((size_t)sb * 30 + 29) * CCH + c0 + fr] = val * __builtin_amdgcn_rcpf(1.0f + __expf(-gate));
            }
        }
    }
}
__device__ __forceinline__ void p3_sample(Frame& F) {
    const bf16* mix = (const bf16*)(F.ws + WS_A); const bf16* Wout = (const bf16*)(F.ws + WS_WOUT); bf16* HB = (bf16*)(F.ws + WS_HB);
    float* rowss = (float*)(F.ws + WS_ROWSS);
    const int lane = F.lane, fr = lane & 15, fq = lane >> 4, R0 = MP + 16 * F.wave;
    for (int job = blockIdx.x; job < 128; job += F.G) {
        const int brow[1] = {job * 16}; f32x4 acc[1];
        skinny_wave<1, 8>(mix, DM, Wout, DM, brow, 0, DM, R0, lane, acc);
        const int col = job * 16 + fr; const float bias = F.in[14][col];
#pragma unroll
        for (int i = 0; i < 4; ++i) {
            const int sb = 16 * F.wave + 4 * fq + i;
            const float v = acc[0][i] + bias + F.in[1][(size_t)sb * DM + col];
            HB[(size_t)(MP + sb) * DM + col] = f2bf1(v);
            float ss = v * v; ss += __shfl_xor(ss, 1); ss += __shfl_xor(ss, 2); ss += __shfl_xor(ss, 4); ss += __shfl_xor(ss, 8);
            if (fr == 0) unsafeAtomicAdd(rowss + MP + sb, ss);
        }
    }
}
__device__ __forceinline__ void p4_sample(Frame& F) {
    const bf16* HB = (const bf16*)(F.ws + WS_HB); const bf16* Wup = (const bf16*)(F.ws + WS_WUP); bf16* ACT = (bf16*)(F.ws + WS_ACT);
    const float* rowss = (const float*)(F.ws + WS_ROWSS);
    const int lane = F.lane, fr = lane & 15, fq = lane >> 4, R0 = MP + 16 * F.wave;
    for (int job = blockIdx.x; job < 256; job += F.G) {
        const int brow[2] = {job * 32, job * 32 + 16}; f32x4 acc[2];
        skinny_wave<2, 4>(HB, DM, Wup, DM, brow, 0, DM, R0, lane, acc);
#pragma unroll
        for (int i = 0; i < 4; ++i) {
            const int sb = 16 * F.wave + 4 * fq + i;
            const float rr = 1.0f / (rowss[MP + sb] * (1.0f / DM) + EPS);
#pragma unroll
            for (int t = 0; t < 2; ++t) { const float a = fmaxf(acc[t][i], 0.f); ACT[(size_t)(MP + sb) * DFF + brow[t] + fr] = f2bf1(a * a * rr); }
        }
    }
}
__device__ __forceinline__ void p5_sample(Frame& F) {
    const bf16* ACT = (const bf16*)(F.ws + WS_ACT); const bf16* Wdn = (const bf16*)(F.ws + WS_WDN); float* part = (float*)(F.ws + WS_PART);
    const int lane = F.lane, fr = lane & 15, fq = lane >> 4, R0 = MP + 16 * F.wave;
    for (int job = blockIdx.x; job < 256; job += F.G) {
        const int ct = job & 127, kh = job >> 7;
        const int brow[1] = {ct * 16}; f32x4 acc[1];
        skinny_wave<1, 8>(ACT, DFF, Wdn, DFF, brow, kh * (DFF / 2), DFF / 2, R0, lane, acc);
#pragma unroll
        for (int i = 0; i < 4; ++i) { const int sb = 16 * F.wave + 4 * fq + i; part[((size_t)kh * MS + sb) * DM + ct * 16 + fr] = acc[0][i]; }
    }
}

__device__ __forceinline__ void p6_final(Frame& F) {
    const int gw = blockIdx.x * NWAVES + F.wave, NGW = F.G * NWAVES;
    const float* rs2 = (const float*)(F.ws + WS_ROWSS2); const float* gf = F.in[18];
    const bf16* YB = (const bf16*)(F.ws + WS_A); const bf16* HB = (const bf16*)(F.ws + WS_HB);
    {
        f32x4 g[8];
#pragma unroll
        for (int j = 0; j < 4; ++j) { g[2 * j] = *(const f32x4*)(gf + (j * 64 + F.lane) * 8); g[2 * j + 1] = *(const f32x4*)(gf + (j * 64 + F.lane) * 8 + 4); }
        for (int m = gw; m < MP; m += NGW) {
            const float r = 1.0f / sqrtf(rs2[m] * (1.0f / DM) + EPS);
            const v4u* yr = (const v4u*)(YB + (size_t)m * DM) + F.lane;
            float* orow = F.out + (size_t)m * DM + F.lane * 8;
            v4u yv[4];
#pragma unroll
            for (int j = 0; j < 4; ++j) yv[j] = yr[64 * j];
#pragma unroll
            for (int j = 0; j < 4; ++j) {
                const f32x4 a = (f32x4){bf_lo(yv[j].x), bf_hi(yv[j].x), bf_lo(yv[j].y), bf_hi(yv[j].y)}, c = (f32x4){bf_lo(yv[j].z), bf_hi(yv[j].z), bf_lo(yv[j].w), bf_hi(yv[j].w)};
                *(f32x4*)(orow + j * 512) = a * r * g[2 * j]; *(f32x4*)(orow + j * 512 + 4) = c * r * g[2 * j + 1];
            }
        }
    }
    for (int sb = NGW - 1 - gw; sb < MS; sb += NGW) {
        f32x4* xr = (f32x4*)(F.out + (size_t)(MP + sb) * DM) + F.lane;
        const v2u* hr = (const v2u*)(HB + (size_t)(MP + sb) * DM) + F.lane;
        const f32x4* p0 = (const f32x4*)((const float*)(F.ws + WS_PART) + (size_t)sb * DM) + F.lane;
        const f32x4* p1 = (const f32x4*)((const float*)(F.ws + WS_PART) + (size_t)(MS + sb) * DM) + F.lane;
        f32x4 v[8]; float s = 0.f;
#pragma unroll
        for (int j = 0; j < 8; ++j) { const v2u hh = hr[64 * j]; v[j] = (f32x4){bf_lo(hh.x), bf_hi(hh.x), bf_lo(hh.y), bf_hi(hh.y)} + p0[64 * j] + p1[64 * j]; s += (v[j].x * v[j].x + v[j].y * v[j].y) + (v[j].z * v[j].z + v[j].w * v[j].w); }
        const float r = 1.0f / sqrtf(wave_sum(s) * (1.0f / DM) + EPS);
#pragma unroll
        for (int j = 0; j < 8; ++j) xr[64 * j] = v[j] * r * *((const f32x4*)gf + F.lane + 64 * j);
    }
}

constexpr int NPHASE = 7;
struct Args { const float* in[19]; float* out; unsigned char* ws; int ph_lo, ph_hi, p2mask, pad; };
__global__ void __launch_bounds__(NWAVES * 64, 2) mk_fwd(Args args) {
    extern __shared__ __attribute__((aligned(16))) unsigned char lds[];
    Frame F;
    F.lds = (LAS unsigned char*)lds;
    F.tid = threadIdx.x; F.lane = F.tid & 63; F.wave = __builtin_amdgcn_readfirstlane(F.tid >> 6); F.G = gridDim.x;
#pragma unroll
    for (int i = 0; i < 19; ++i) F.in[i] = args.in[i];
    F.out = args.out; F.ws = args.ws;
    const int lo = args.ph_lo, hi = args.ph_hi;
#define IN(k) (lo <= (k) && (k) < hi)
#define SEAM(k) do { if (IN(k) && IN((k) + 1)) { cg::this_grid().sync(); } } while (0)
    bf16* Win = (bf16*)(F.ws + WS_WIN); bf16* Wout = (bf16*)(F.ws + WS_WOUT); bf16* Wup = (bf16*)(F.ws + WS_WUP); bf16* Wdn = (bf16*)(F.ws + WS_WDN);
    bf16* XA = (bf16*)(F.ws + WS_A); bf16* HB = (bf16*)(F.ws + WS_HB); bf16* ACT = (bf16*)(F.ws + WS_ACT);
    float* rowss = (float*)(F.ws + WS_ROWSS); float* rowss2 = (float*)(F.ws + WS_ROWSS2);

    if (IN(0)) { p0_prologue(F); }
    SEAM(0);
    if (IN(1)) {
        pg8::Gemm g{XA, Win, MP, IN_DIM, DM}; pg8::StaticOrder S; S.init(MP, IN_DIM, F.G, (int)blockIdx.x);
        pg8::EpiIn E{(bf16*)(F.ws + WS_Q), (bf16*)(F.ws + WS_K), (bf16*)(F.ws + WS_V), (bf16*)(F.ws + WS_U), (const float*)(F.ws + WS_BPERM), (const float*)(F.ws + WS_ROPE), F.out};
        pg8::gemm_phase<pg8::EpiIn, pg8::StaticOrder, true, true>(F.lds + RING_OFF, g, S, E);
        p1_sample(F);
    }
    SEAM(1);
    if (IN(2)) { p2_mixers(F, args.p2mask); }
    SEAM(2);
    if (IN(3)) {
        pg8::Gemm g{XA, Wout, MP, DM, DM}; pg8::StaticOrder S; S.init(MP, DM, F.G, (int)blockIdx.x);
        pg8::EpiOut E{F.in[0], F.in[14], HB, rowss};
        pg8::gemm_phase<pg8::EpiOut, pg8::StaticOrder, true, true>(F.lds + RING_OFF, g, S, E);
        p3_sample(F);
    }
    SEAM(3);
    if (IN(4)) {
        pg8::Gemm g{HB, Wup, MP, DFF, DM}; pg8::StaticOrder S; S.init(MP, DFF, F.G, (int)blockIdx.x);
        pg8::EpiUp E{ACT, rowss};
        pg8::gemm_phase<pg8::EpiUp, pg8::StaticOrder, true, true>(F.lds + RING_OFF, g, S, E);
        p4_sample(F);
    }
    SEAM(4);
    if (IN(5)) {
        pg8::Gemm g{ACT, Wdn, MP, DM, DFF}; pg8::StaticOrder S; S.init(MP, DM, F.G, (int)blockIdx.x);
        pg8::EpiDown E{HB, XA, rowss2};
        pg8::gemm_phase<pg8::EpiDown, pg8::StaticOrder, true, true>(F.lds + RING_OFF, g, S, E);
        p5_sample(F);
    }
    SEAM(5);
    if (IN(6)) { p6_final(F); }
#undef IN
#undef SEAM
}

extern "C" void kernel_launch(void* const* d_in, const int* in_sizes, int n_in, void* d_out, int out_size, void* d_ws, size_t ws_size, hipStream_t stream) {
    static int grid = 0;
    if (grid == 0) {
        int dev = 0, cus = 0, per_cu = 0;
        (void)hipGetDevice(&dev);
        (void)hipDeviceGetAttribute(&cus, hipDeviceAttributeMultiprocessorCount, dev);
        if (hipFuncSetAttribute((const void*)mk_fwd, hipFuncAttributeMaxDynamicSharedMemorySize, LDS_BYTES) != hipSuccess) fprintf(stderr, "kernel_launch: hipFuncSetAttribute failed\n");
        if (hipOccupancyMaxActiveBlocksPerMultiprocessor(&per_cu, (const void*)mk_fwd, NWAVES * 64, LDS_BYTES) != hipSuccess || per_cu < 1) per_cu = 1;
        (void)hipGetLastError();
        if (cus <= 0) cus = 256;
        grid = cus * per_cu;
        if (n_in != 19 || ws_size < 1024 * MiB) fprintf(stderr, "kernel_launch: unexpected n_in %d / ws_size %zu\n", n_in, ws_size);
    }
    Args a{};
    for (int i = 0; i < 19; ++i) a.in[i] = (const float*)d_in[i];
    a.out = (float*)d_out; a.ws = (unsigned char*)d_ws; a.p2mask = 15;
#if MK_LAUNCHES == 1
    a.ph_lo = 0; a.ph_hi = NPHASE;
    void* params[] = {&a};
    hipError_t e = hipLaunchCooperativeKernel((const void*)mk_fwd, dim3(grid), dim3(NWAVES * 64), params, LDS_BYTES, stream);
    if (e != hipSuccess) fprintf(stderr, "cooperative launch failed: %s (grid %d)\n", hipGetErrorString(e), grid);
#else
    for (int p = 0; p < NPHASE; ++p) {
        a.ph_lo = p; a.ph_hi = p + 1;
        hipLaunchKernelGGL(mk_fwd, dim3(grid), dim3(NWAVES * 64), LDS_BYTES, stream, a);
        if (p == 2 && PROBE_REP > 0) { a.p2mask = PROBE_REP; hipLaunchKernelGGL(mk_fwd, dim3(grid), dim3(NWAVES * 64), LDS_BYTES, stream, a); a.p2mask = 15; }
    }
#endif
}
```

```cpp
#include <hip/hip_runtime.h>
#include <hip/hip_cooperative_groups.h>
#include <cstdio>
#include <cstdint>
namespace cg = cooperative_groups;

#ifndef PROBE_REP
#define PROBE_REP -1
#endif
#ifndef MK_LAUNCHES
#define MK_LAUNCHES 1
#endif

constexpr int DM = 2048, NBATCH = 16, SEQ = 2048, MP = NBATCH * SEQ, MS = 128, MR = MP + MS, RPAD = 33024;
constexpr int QD = 1024, KVD = 256, CCH = 1024, IN_DIM = 3584, DFF = 8192, CONVW = 31;
constexpr float EPS = 1e-5f;
constexpr float C2 = 0.125f * 1.4426950408889634f;
constexpr float LOG2E = 1.4426950408889634f;
constexpr size_t O_Y = 0, O_PK = 67371008, O_PV = 67895296, O_PC = 68419584, O_SK = 68911104, O_SV = 73105408, O_SC = 77299712;
constexpr size_t MiB = 1u << 20;
constexpr size_t WS_WIN = 0, WS_WOUT = 14 * MiB, WS_WUP = 22 * MiB, WS_WDN = 54 * MiB;
constexpr size_t WS_ROPE = 86 * MiB, WS_BPERM = 86 * MiB + 256 * 1024, WS_ROWSS = 86 * MiB + 512 * 1024, WS_ROWSS2 = 86 * MiB + 768 * 1024;
constexpr size_t WS_PART = 87 * MiB;
constexpr size_t WS_A = 90 * MiB;
constexpr size_t WS_Q = 219 * MiB;
constexpr size_t WS_K = WS_Q + (size_t)RPAD * 1024 * 2;
constexpr size_t WS_V = WS_K + (size_t)RPAD * 256 * 2;
constexpr size_t WS_U = WS_V + (size_t)RPAD * 256 * 2;
constexpr size_t WS_HB = WS_Q;
constexpr size_t WS_ACT = 381 * MiB;
static_assert(WS_U + (size_t)RPAD * 1024 * 2 <= WS_ACT && WS_HB + (size_t)RPAD * 2048 * 2 <= WS_ACT, "ws map");
static_assert(WS_ACT + (size_t)RPAD * 8192 * 2 <= 1024 * MiB, "ws map end");

namespace pg8 {
#define PG8_LAS __attribute__((address_space(3)))
typedef unsigned short bf16_t;
typedef short bf16x8 __attribute__((ext_vector_type(8)));
typedef float f32x4 __attribute__((ext_vector_type(4)));
typedef unsigned u32x4 __attribute__((ext_vector_type(4)));
constexpr int BM = 256, BK = 64, HALF = 128, HTB = HALF * BK * 2  , STAGE_BYTES = 8 * HTB, NXCD = 8, WGM = 8;

__host__ __device__ __forceinline__ int lds_byte(int r, int c) { const int st = (r >> 4) * 2 + (c >> 5), rr = r & 15, cc = c & 31, ob = rr * 64 + cc * 2; return st * 1024 + (ob ^ (((ob >> 9) & 1) << 5)); }
__host__ __device__ __forceinline__ void stage_rc(int b, int& R, int& C) { const int st = b / 1024, sb = b % 1024, swz = sb ^ (((sb >> 9) & 1) << 5); R = (st >> 1) * 16 + swz / 64; C = (st & 1) * 32 + (swz % 64) / 2; }
__host__ __device__ __forceinline__ int perm32(int rho) { const int n = rho >> 4, i = rho & 15; return 8 * (i >> 2) + 4 * n + (i & 3); }

struct Unit { int pm, pn; };
struct Gemm { const bf16_t* A; const bf16_t* Bt; int M, N, K; };

struct StaticOrder {
    int nM, nN, nwg, G, c;
    __host__ __device__ void init(int M, int N, int G_, int c_) { nM = M / BM; nN = N / BM; nwg = nM * nN; G = G_; c = c_; }
    __host__ __device__ bool next(int i, Unit& u) const {
        const long L = (long)i * G + c; if (L >= nwg) return false;
        int wgid = (int)L; { const int q = nwg / NXCD, r = nwg % NXCD, xcd = wgid % NXCD, off = wgid / NXCD; wgid = (xcd < r ? xcd * (q + 1) : r * (q + 1) + (xcd - r) * q) + off; }
        const int nig = WGM * nN, gid = wgid / nig, fm = gid * WGM, gsz = (nM - fm) < WGM ? (nM - fm) : WGM;
        u.pm = fm + ((wgid % nig) % gsz); u.pn = (wgid % nig) / gsz; return true;
    }
    __device__ __forceinline__ void a_ready(const Unit&) const {}
    __device__ __forceinline__ void done(const Unit&) const {}
};

typedef float f32x2_t __attribute__((ext_vector_type(2)));
typedef __bf16 bf16x2_t __attribute__((ext_vector_type(2)));
__device__ __forceinline__ unsigned pk2(float lo, float hi) { f32x2_t v = {lo, hi}; bf16x2_t b = __builtin_convertvector(v, bf16x2_t); return __builtin_bit_cast(unsigned, b); }
__device__ __forceinline__ u32x4 pk8(const f32x4& a, const f32x4& b) { u32x4 w; w.x = pk2(a[0], a[1]); w.y = pk2(a[2], a[3]); w.z = pk2(b[0], b[1]); w.w = pk2(b[2], b[3]); return w; }
__device__ __forceinline__ float sumsq8(const f32x4& a, const f32x4& b) { return ((a[0] * a[0] + a[1] * a[1]) + (a[2] * a[2] + a[3] * a[3])) + ((b[0] * b[0] + b[1] * b[1]) + (b[2] * b[2] + b[3] * b[3])); }

struct EpiIn {
    static constexpr bool PERM = true, AFTER_DRAIN = false;
    bf16_t *Q, *Kb, *Vp, *U; const float* bias; const float* rope; float* out;
    __device__ __forceinline__ void operator()(const f32x4 (&acc)[2][2][4][2], const Unit& u, int wr, int wc, int fr, int fq) const {
        const int pn = u.pn, colw = wc * 32 + 8 * fq;
        f32x4 bv[2][2];
#pragma unroll
        for (int bj = 0; bj < 2; ++bj)
#pragma unroll
            for (int n = 0; n < 2; ++n) bv[bj][n] = *(const f32x4*)(bias + pn * 256 + bj * HALF + colw + 4 * n);
        const bool dorope = (pn < 5) && ((wc & 1) == 0);
#pragma unroll
        for (int ai = 0; ai < 2; ++ai)
#pragma unroll
            for (int m = 0; m < 4; ++m) {
                const int row = u.pm * BM + ai * HALF + wr * 64 + m * 16 + fr;
                const bool isP = row < MP, isS = (!isP) && row < MR;
                const int t = row & (SEQ - 1), b = row >> 11;
                if (pn >= 6) {
                    const int c = (pn - 6) * 128 + colw;
                    f32x4 o[2];
#pragma unroll
                    for (int n = 0; n < 2; ++n) {
                        const f32x4 val = acc[ai][0][m][n] + bv[0][n], gate = acc[ai][1][m][n] + bv[1][n];
#pragma unroll
                        for (int e = 0; e < 4; ++e) o[n][e] = val[e] * __builtin_amdgcn_rcpf(1.0f + __expf(-gate[e]));
                    }
                    *(u32x4*)(U + (size_t)row * CCH + c) = pk8(o[0], o[1]);
                    float* dst = nullptr;
                    if (isP && t >= SEQ - 30) dst = out + O_PC + ((size_t)(b * 30 + t - (SEQ - 30))) * CCH + c;
                    if (isS) dst = out + O_SC + ((size_t)((row - MP) * 30 + 29)) * CCH + c;
                    if (dst) { *(f32x4*)dst = o[0]; *(f32x4*)(dst + 4) = o[1]; }
                } else {
                    f32x4 c0, c1, s0, s1;
                    if (dorope) { const float* rp = rope + (size_t)(isP ? t : SEQ) * 16; c0 = *(const f32x4*)rp; c1 = *(const f32x4*)(rp + 4); s0 = *(const f32x4*)(rp + 8); s1 = *(const f32x4*)(rp + 12);
                        if (fq == 0) { s0 = -s0; s1 = -s1; } }
#pragma unroll
                    for (int bj = 0; bj < 2; ++bj) {
                        f32x4 v0 = acc[ai][bj][m][0] + bv[bj][0], v1 = acc[ai][bj][m][1] + bv[bj][1];
                        if (dorope) {
                            f32x4 p0, p1;
#pragma unroll
                            for (int e = 0; e < 4; ++e) { p0[e] = __shfl_xor(v0[e], 16); p1[e] = __shfl_xor(v1[e], 16); }
                            if (fq < 2) { v0 = v0 * c0 + p0 * s0; v1 = v1 * c1 + p1 * s1; }
                        }
                        const int col = bj * HALF + colw;
                        const u32x4 w = pk8(v0, v1);
                        if (pn < 4) {
                            const int qc = pn * 256 + col, hq = qc >> 6, d = qc & 63;
                            *(u32x4*)(Q + (size_t)(b * 16 + hq) * (SEQ * 64) + (size_t)(((((t >> 5) * 4 + (d >> 4)) * 2 + ((d >> 3) & 1)) * 32 + (t & 31)) * 8)) = w; }
                        else {
                            if (pn == 4) {
                                const int kvh = col >> 6, d = col & 63;
                                *(u32x4*)(Kb + (size_t)(b * 4 + kvh) * (SEQ * 64) + (size_t)(((((t >> 5) * 4 + (d >> 4)) * 2 + ((d >> 3) & 1)) * 32 + (t & 31)) * 8)) = w; }
                            else if (isP) {
                                const int kvh = col >> 6, d = col & 63, kb = t >> 5, kap = t & 31;
                                const int i = kap & 3, hh = (kap >> 2) & 1, j = kap >> 3, s = j >> 1, e0 = 4 * (j & 1) + i;
                                bf16_t* vp = Vp + (size_t)(b * 4 + kvh) * (SEQ * 64) + (size_t)((((kb * 2 + (d >> 5)) * 2 + s) * 2 + hh) * 256) + (d & 31) * 8 + e0;
                                vp[0] = (bf16_t)(w.x & 0xffffu); vp[8] = (bf16_t)(w.x >> 16); vp[16] = (bf16_t)(w.y & 0xffffu); vp[24] = (bf16_t)(w.y >> 16);
                                vp[32] = (bf16_t)(w.z & 0xffffu); vp[40] = (bf16_t)(w.z >> 16); vp[48] = (bf16_t)(w.w & 0xffffu); vp[56] = (bf16_t)(w.w >> 16);
                            }
                            float* dst = nullptr;
                            if (isP && t >= SEQ - 128) dst = out + (pn == 4 ? O_PK : O_PV) + ((size_t)(b * 128 + t - (SEQ - 128))) * KVD + col;
                            if (isS) dst = out + (pn == 4 ? O_SK : O_SV) + ((size_t)((row - MP) * 128 + 127)) * KVD + col;
                            if (dst) { *(f32x4*)dst = v0; *(f32x4*)(dst + 4) = v1; }
                        }
                    }
                }
            }
    }
};

struct EpiOut {
    static constexpr bool PERM = true, AFTER_DRAIN = false;
    const float *xp, *bias; bf16_t* HB; float* rowss;
    __device__ __forceinline__ void operator()(const f32x4 (&acc)[2][2][4][2], const Unit& u, int wr, int wc, int fr, int fq) const {
        const int colb = u.pn * BM + wc * 32 + 8 * fq;
        f32x4 bv[2][2];
#pragma unroll
        for (int bj = 0; bj < 2; ++bj)
#pragma unroll
            for (int n = 0; n < 2; ++n) bv[bj][n] = *(const f32x4*)(bias + colb + bj * HALF + 4 * n);
#pragma unroll
        for (int am = 0; am < 4; ++am) {
            const int ai = am >> 1, mb = (am & 1) * 2;
            f32x4 xv[4][2][2];
#pragma unroll
            for (int m = mb; m < mb + 2; ++m) { const float* xr = xp + (size_t)(u.pm * BM + ai * HALF + wr * 64 + m * 16 + fr) * DM + colb;
#pragma unroll
                for (int bj = 0; bj < 2; ++bj) { xv[m][bj][0] = *(const f32x4*)(xr + bj * HALF); xv[m][bj][1] = *(const f32x4*)(xr + bj * HALF + 4); } }
            __builtin_amdgcn_sched_barrier(0);
#pragma unroll
            for (int m = mb; m < mb + 2; ++m) {
                const int row = u.pm * BM + ai * HALF + wr * 64 + m * 16 + fr;
                float ss = 0.f;
#pragma unroll
                for (int bj = 0; bj < 2; ++bj) {
                    const int col = colb + bj * HALF;
                    const f32x4 v0 = acc[ai][bj][m][0] + bv[bj][0] + xv[m][bj][0], v1 = acc[ai][bj][m][1] + bv[bj][1] + xv[m][bj][1];
                    *(u32x4*)(HB + (size_t)row * DM + col) = pk8(v0, v1);
                    ss += sumsq8(v0, v1);
                }
                ss += __shfl_xor(ss, 16); ss += __shfl_xor(ss, 32);
                if (fq == 0) unsafeAtomicAdd(rowss + row, ss);
            }
        }
    }
};

struct EpiUp {
    static constexpr bool PERM = true, AFTER_DRAIN = false;
    bf16_t* ACT; const float* rowss;
    __device__ __forceinline__ void operator()(const f32x4 (&acc)[2][2][4][2], const Unit& u, int wr, int wc, int fr, int fq) const {
        const int colb = u.pn * BM + wc * 32 + 8 * fq;
        float rs[2][4];
#pragma unroll
        for (int ai = 0; ai < 2; ++ai)
#pragma unroll
            for (int m = 0; m < 4; ++m) rs[ai][m] = rowss[u.pm * BM + ai * HALF + wr * 64 + m * 16 + fr];
        __builtin_amdgcn_sched_barrier(0);
#pragma unroll
        for (int ai = 0; ai < 2; ++ai)
#pragma unroll
            for (int m = 0; m < 4; ++m) {
                const int row = u.pm * BM + ai * HALF + wr * 64 + m * 16 + fr;
                const float rr = 1.0f / (rs[ai][m] * (1.0f / DM) + EPS);
#pragma unroll
                for (int bj = 0; bj < 2; ++bj) {
                    f32x4 v0 = acc[ai][bj][m][0], v1 = acc[ai][bj][m][1];
#pragma unroll
                    for (int e = 0; e < 4; ++e) { const float a = fmaxf(v0[e], 0.f), c = fmaxf(v1[e], 0.f); v0[e] = a * a * rr; v1[e] = c * c * rr; }
                    *(u32x4*)(ACT + (size_t)row * DFF + colb + bj * HALF) = pk8(v0, v1);
                }
            }
    }
};

__device__ __forceinline__ f32x4 bfx4_lo(const u32x4& w) { return (f32x4){__uint_as_float(w.x << 16), __uint_as_float(w.x & 0xffff0000u), __uint_as_float(w.y << 16), __uint_as_float(w.y & 0xffff0000u)}; }
__device__ __forceinline__ f32x4 bfx4_hi(const u32x4& w) { return (f32x4){__uint_as_float(w.z << 16), __uint_as_float(w.z & 0xffff0000u), __uint_as_float(w.w << 16), __uint_as_float(w.w & 0xffff0000u)}; }
struct EpiDown {
    static constexpr bool PERM = true, AFTER_DRAIN = false;
    const bf16_t* HB; bf16_t* YB; float* rowss;
    __device__ __forceinline__ void operator()(const f32x4 (&acc)[2][2][4][2], const Unit& u, int wr, int wc, int fr, int fq) const {
        const int colb = u.pn * BM + wc * 32 + 8 * fq;
#pragma unroll
        for (int ai = 0; ai < 2; ++ai) {
            u32x4 hwv[2][4][2];
#pragma unroll
            for (int m = 0; m < 4; ++m)
#pragma unroll
                for (int bj = 0; bj < 2; ++bj) hwv[ai][m][bj] = *(const u32x4*)(HB + (size_t)(u.pm * BM + ai * HALF + wr * 64 + m * 16 + fr) * DM + colb + bj * HALF);
            __builtin_amdgcn_sched_barrier(0);
#pragma unroll
            for (int m = 0; m < 4; ++m) {
                const int row = u.pm * BM + ai * HALF + wr * 64 + m * 16 + fr;
                float ss = 0.f;
#pragma unroll
                for (int bj = 0; bj < 2; ++bj) {
                    const size_t off = (size_t)row * DM + colb + bj * HALF;
                    const u32x4 hw = hwv[ai][m][bj];
                    const f32x4 v0 = acc[ai][bj][m][0] + bfx4_lo(hw), v1 = acc[ai][bj][m][1] + bfx4_hi(hw);
                    *(u32x4*)(YB + off) = pk8(v0, v1);
                    ss += sumsq8(v0, v1);
                }
                ss += __shfl_xor(ss, 16); ss += __shfl_xor(ss, 32);
                if (fq == 0) unsafeAtomicAdd(rowss + row, ss);
            }
        }
    }
};

template <class Epi, class Sched, bool ALIGN_EPI = false, bool SP2 = false>
__device__ __forceinline__ void gemm_phase(PG8_LAS unsigned char* lds, const Gemm g, const Sched& S, const Epi& E) {
    const int tid = threadIdx.x, wid = __builtin_amdgcn_readfirstlane(tid >> 6), lane = tid & 63, wr = wid >> 2, wc = wid & 3, fr = lane & 15, fq = lane >> 4;
    const int K = g.K, nt = K / BK;
    unsigned voffA[2], voffB[2];
#pragma unroll
    for (int i = 0; i < 2; ++i) { int R, C; stage_rc(tid * 16 + i * 8192, R, C); const int Rb = Epi::PERM ? ((R & ~31) + perm32(R & 31)) : R;
        voffA[i] = (unsigned)(R * K + C) * 2u; voffB[i] = (unsigned)(Rb * K + C) * 2u; }
    const size_t kstep = (size_t)(BK * 2);
    const size_t hstep = (size_t)HALF * K * 2;
    const size_t tstep = 2 * hstep;
    const unsigned ldsw = (unsigned)wid * 1024u;
    const int aoff = lds_byte(wr * 64 + fr, fq * 8), boff = lds_byte(wc * 32 + fr, fq * 8);
#define PG8_SA(b, h) (((b) * 2 + (h)) * HTB)
#define PG8_SB(b, h) ((4 + (b) * 2 + (h)) * HTB)
#define PG8_STAGE(bufoff, gbase, voff) do { _Pragma("unroll") for (int _i = 0; _i < 2; ++_i) \
        __builtin_amdgcn_global_load_lds((const unsigned*)((const char*)(gbase) + (voff)[_i]), (PG8_LAS unsigned*)(lds + (bufoff) + ldsw + _i * 8192), 16, 0, 0); } while (0)
#define PG8_LDA(dst, b, h) do { _Pragma("unroll") for (int m = 0; m < 4; ++m) _Pragma("unroll") for (int k = 0; k < 2; ++k) dst[m][k] = *(const PG8_LAS bf16x8*)(lds + PG8_SA(b, h) + aoff + m * 2048 + k * 1024); } while (0)
#define PG8_LDB(dst, b, h) do { _Pragma("unroll") for (int n = 0; n < 2; ++n) _Pragma("unroll") for (int k = 0; k < 2; ++k) dst[n][k] = *(const PG8_LAS bf16x8*)(lds + PG8_SB(b, h) + boff + n * 2048 + k * 1024); } while (0)
#define PG8_MMA(ai, bj, At, Bt) do { __builtin_amdgcn_s_setprio(1); _Pragma("unroll") for (int m = 0; m < 4; ++m) _Pragma("unroll") for (int n = 0; n < 2; ++n) _Pragma("unroll") for (int k = 0; k < 2; ++k) \
        acc[ai][bj][m][n] = __builtin_amdgcn_mfma_f32_16x16x32_bf16(Bt[n][k], At[m][k], acc[ai][bj][m][n], 0, 0, 0); __builtin_amdgcn_s_setprio(0); } while (0)
#define PG8_WAIT_V(n) asm volatile("s_waitcnt vmcnt(" #n ")" ::: "memory")
#define PG8_WAIT_L(n) asm volatile("s_waitcnt lgkmcnt(" #n ")" ::: "memory")
#define PG8_BAR __builtin_amdgcn_s_barrier()
#define PG8_SCHED __builtin_amdgcn_sched_barrier(0)
    Unit cur, nxt; int ui = 0;
    if (!S.next(0, cur)) return;
    f32x4 acc[2][2][4][2];
#pragma unroll
    for (int a = 0; a < 2; ++a)
#pragma unroll
        for (int b = 0; b < 2; ++b)
#pragma unroll
            for (int m = 0; m < 4; ++m)
#pragma unroll
                for (int n = 0; n < 2; ++n) acc[a][b][m][n] = (f32x4){0.f, 0.f, 0.f, 0.f};
    bf16x8 At[4][2], B0[2][2], B1[2][2];
    const char* cA = (const char*)g.A + (size_t)cur.pm * tstep; const char* cB = (const char*)g.Bt + (size_t)cur.pn * tstep;
    S.a_ready(cur);
    if constexpr (SP2) {
        PG8_STAGE(PG8_SB(0, 0), cB, voffB); PG8_STAGE(PG8_SB(0, 1), cB + hstep, voffB); PG8_STAGE(PG8_SA(0, 0), cA, voffA); PG8_STAGE(PG8_SA(0, 1), cA + hstep, voffA);
        if (wr == 1) PG8_BAR;
        PG8_WAIT_V(2); PG8_BAR;
        PG8_STAGE(PG8_SB(1, 0), cB + kstep, voffB); PG8_STAGE(PG8_SA(1, 0), cA + kstep, voffA); PG8_STAGE(PG8_SB(1, 1), cB + hstep + kstep, voffB);
        PG8_WAIT_V(6); PG8_BAR;
    } else {
        PG8_STAGE(PG8_SB(0, 0), cB, voffB); PG8_STAGE(PG8_SA(0, 0), cA, voffA); PG8_STAGE(PG8_SB(0, 1), cB + hstep, voffB); PG8_STAGE(PG8_SA(0, 1), cA + hstep, voffA);
        if (wr == 1) PG8_BAR;
        PG8_WAIT_V(4); PG8_BAR;
        PG8_STAGE(PG8_SB(1, 0), cB + kstep, voffB); PG8_STAGE(PG8_SA(1, 0), cA + kstep, voffA); PG8_STAGE(PG8_SB(1, 1), cB + hstep + kstep, voffB);
        PG8_WAIT_V(6); PG8_BAR;
    }
    for (;;) {
        const bool has_next = S.next(ui + 1, nxt);
        const char* nA = has_next ? (const char*)g.A + (size_t)nxt.pm * tstep : cA; const char* nB = has_next ? (const char*)g.Bt + (size_t)nxt.pn * tstep : cB;
        for (int t = 0; t < nt; t += 2) {
            const bool last = (t == nt - 2);
            const char* a1 = cA + (size_t)(t + 1) * kstep;
            const char* a2 = last ? nA : cA + (size_t)(t + 2) * kstep; const char* b2 = last ? nB : cB + (size_t)(t + 2) * kstep;
            const char* a3 = a2 + kstep; const char* b3 = b2 + kstep;
            if (last && has_next) S.a_ready(nxt);
            if constexpr (SP2) {
            PG8_LDB(B0, 0, 0); PG8_LDB(B1, 0, 1); PG8_SCHED; PG8_LDA(At, 0, 0); PG8_STAGE(PG8_SA(1, 1), a1 + hstep, voffA);
            PG8_WAIT_V(8); PG8_WAIT_L(0); PG8_BAR; PG8_MMA(0, 0, At, B0); PG8_MMA(0, 1, At, B1); PG8_BAR; PG8_SCHED;
            PG8_LDA(At, 0, 1); PG8_STAGE(PG8_SB(0, 0), b2, voffB); PG8_STAGE(PG8_SB(0, 1), b2 + hstep, voffB); PG8_STAGE(PG8_SA(0, 0), a2, voffA);
            PG8_WAIT_V(8); PG8_WAIT_L(0); PG8_BAR; PG8_MMA(1, 0, At, B0); PG8_MMA(1, 1, At, B1); PG8_BAR; PG8_SCHED;
            PG8_LDB(B0, 1, 0); PG8_LDB(B1, 1, 1); PG8_SCHED; PG8_LDA(At, 1, 0); PG8_STAGE(PG8_SA(0, 1), a2 + hstep, voffA);
            PG8_WAIT_V(8); PG8_WAIT_L(0); PG8_BAR; PG8_MMA(0, 0, At, B0); PG8_MMA(0, 1, At, B1); PG8_BAR; PG8_SCHED;
            PG8_LDA(At, 1, 1); PG8_STAGE(PG8_SB(1, 0), b3, voffB); PG8_STAGE(PG8_SB(1, 1), b3 + hstep, voffB); PG8_STAGE(PG8_SA(1, 0), a3, voffA);
            PG8_WAIT_V(8); PG8_WAIT_L(0); PG8_BAR; PG8_MMA(1, 0, At, B0); PG8_MMA(1, 1, At, B1); PG8_BAR; PG8_SCHED;
            } else {
            PG8_LDB(B0, 0, 0); PG8_SCHED; PG8_LDA(At, 0, 0); PG8_STAGE(PG8_SA(1, 1), a1 + hstep, voffA);
            PG8_WAIT_L(8); PG8_BAR; PG8_WAIT_L(0); PG8_MMA(0, 0, At, B0); PG8_BAR; PG8_SCHED;
            PG8_LDB(B1, 0, 1); PG8_STAGE(PG8_SB(0, 0), b2, voffB);
            PG8_BAR; PG8_WAIT_L(0); PG8_MMA(0, 1, At, B1); PG8_BAR;
            PG8_LDA(At, 0, 1); PG8_STAGE(PG8_SA(0, 0), a2, voffA);
            PG8_BAR; PG8_WAIT_L(0); PG8_MMA(1, 0, At, B0); PG8_BAR; PG8_SCHED;
            PG8_STAGE(PG8_SB(0, 1), b2 + hstep, voffB);
            PG8_WAIT_V(6); PG8_BAR; PG8_MMA(1, 1, At, B1); PG8_BAR;
            PG8_LDB(B0, 1, 0); PG8_SCHED; PG8_LDA(At, 1, 0); PG8_STAGE(PG8_SA(0, 1), a2 + hstep, voffA);
            PG8_WAIT_L(8); PG8_BAR; PG8_WAIT_L(0); PG8_MMA(0, 0, At, B0); PG8_BAR; PG8_SCHED;
            PG8_LDB(B1, 1, 1); PG8_STAGE(PG8_SB(1, 0), b3, voffB);
            PG8_BAR; PG8_WAIT_L(0); PG8_MMA(0, 1, At, B1); PG8_BAR;
            PG8_LDA(At, 1, 1); PG8_STAGE(PG8_SA(1, 0), a3, voffA);
            PG8_BAR; PG8_WAIT_L(0); PG8_MMA(1, 0, At, B0); PG8_BAR; PG8_SCHED;
            PG8_STAGE(PG8_SB(1, 1), b3 + hstep, voffB);
            PG8_WAIT_V(6); PG8_BAR; PG8_MMA(1, 1, At, B1); PG8_BAR;
            }
        }
        if constexpr (ALIGN_EPI) { if (wr == 0) PG8_BAR; }
        if constexpr (!Epi::AFTER_DRAIN) { E(acc, cur, wr, wc, fr, fq); S.done(cur); }
        if (!has_next) break;
#pragma unroll
        for (int a = 0; a < 2; ++a)
#pragma unroll
            for (int b = 0; b < 2; ++b)
#pragma unroll
                for (int m = 0; m < 4; ++m)
#pragma unroll
                    for (int n = 0; n < 2; ++n) acc[a][b][m][n] = (f32x4){0.f, 0.f, 0.f, 0.f};
        cur = nxt; cA = nA; cB = nB; ++ui;
        if constexpr (ALIGN_EPI) { if (wr == 1) PG8_BAR; }
    }
    PG8_WAIT_V(0);
    if constexpr (!ALIGN_EPI) { if (wr == 0) PG8_BAR; }
    PG8_BAR;
    if constexpr (Epi::AFTER_DRAIN) { E.fused(acc, cur, wr, wc, fr, fq, lds, wid, lane); S.done(cur); }
#undef PG8_SA
#undef PG8_SB
#undef PG8_STAGE
#undef PG8_LDA
#undef PG8_LDB
#undef PG8_MMA
#undef PG8_WAIT_V
#undef PG8_WAIT_L
#undef PG8_BAR
#undef PG8_SCHED
}
}

constexpr int RING_OFF = 0, RING_BYTES = 131072;
constexpr int LDS_BYTES = 147456;
constexpr int NWAVES = 8;
#define LAS __attribute__((address_space(3)))
typedef unsigned short bf16;
typedef unsigned v4u __attribute__((ext_vector_type(4)));
typedef unsigned v2u __attribute__((ext_vector_type(2)));
typedef float f32x4 __attribute__((ext_vector_type(4)));
typedef float f32x16 __attribute__((ext_vector_type(16)));
typedef short bf16x8 __attribute__((ext_vector_type(8)));
#define LDS_WAIT() asm volatile("s_waitcnt lgkmcnt(0)" ::: "memory")
using pg8::pk2;

__device__ __forceinline__ float wave_sum(float v) {
#pragma unroll
    for (int o = 1; o < 64; o <<= 1) v += __shfl_xor(v, o);
    return v;
}
__device__ __forceinline__ float wave_max(float v) {
#pragma unroll
    for (int o = 1; o < 64; o <<= 1) v = fmaxf(v, __shfl_xor(v, o));
    return v;
}
__device__ __forceinline__ float bf_lo(unsigned x) { return __uint_as_float(x << 16); }
__device__ __forceinline__ float bf_hi(unsigned x) { return __uint_as_float(x & 0xffff0000u); }

struct Frame {
    LAS unsigned char* lds;
    int tid, lane, wave, G;
    const float* in[19]; float* out; unsigned char* ws;
};

__device__ __forceinline__ void p0_transpose_item(const float* W, int K, int N, bf16* WT, int k0, int n0, int drow0, const float* kscale, LAS float* scr, int lane) {
    float tv[32];
#pragma unroll
    for (int i = 0; i < 32; ++i) { const int kk = 2 * i + (lane >> 5); tv[i] = W[(size_t)(k0 + kk) * N + n0 + (lane & 31)]; }
    if (kscale) {
#pragma unroll
        for (int i = 0; i < 32; ++i) tv[i] *= kscale[k0 + 2 * i + (lane >> 5)];
    }
#pragma unroll
    for (int i = 0; i < 32; ++i) scr[(2 * i + (lane >> 5)) * 33 + (lane & 31)] = tv[i];
    LDS_WAIT(); asm volatile("" ::: "memory");
    const int c = lane & 7;
#pragma unroll
    for (int j = 0; j < 4; ++j) { const int n = (lane >> 3) + 8 * j; const LAS float* s = scr + (8 * c) * 33 + n;
        v4u o; o.x = pk2(s[0 * 33], s[1 * 33]); o.y = pk2(s[2 * 33], s[3 * 33]); o.z = pk2(s[4 * 33], s[5 * 33]); o.w = pk2(s[6 * 33], s[7 * 33]);
        *(v4u*)(WT + (size_t)(drow0 + n) * K + k0 + 8 * c) = o; }
    LDS_WAIT(); asm volatile("" ::: "memory");
}
__device__ __forceinline__ int inproj_row(int n) {
    if (n < 1536) return n;
    if (n < 2560) { const int c = n - 1536; return 1536 + (c >> 7) * 256 + (c & 127); }
    const int c = n - 2560; return 1536 + (c >> 7) * 256 + 128 + (c & 127);
}
__device__ __forceinline__ void sincos_acc(float ang, float& c, float& s) {
    const double x = (double)ang;
    const double n = rint(x * 0.63661977236758134308);
    double r = fma(-n, 1.57079632679489655800, x); r = fma(-n, 6.12323399573676603587e-17, r);
    const int q = ((int)n) & 3;
    const double r2 = r * r;
    const double sp = r * (1.0 + r2 * (-1.0 / 6 + r2 * (1.0 / 120 + r2 * (-1.0 / 5040 + r2 * (1.0 / 362880 + r2 * (-1.0 / 39916800 + r2 * (1.0 / 6227020800.0)))))));
    const double cp = 1.0 + r2 * (-0.5 + r2 * (1.0 / 24 + r2 * (-1.0 / 720 + r2 * (1.0 / 40320 + r2 * (-1.0 / 3628800 + r2 * (1.0 / 479001600 + r2 * (-1.0 / 87178291200.0)))))));
    const double ss = (q == 0) ? sp : (q == 1) ? cp : (q == 2) ? -sp : -cp;
    const double cc = (q == 0) ? cp : (q == 1) ? -sp : (q == 2) ? -cp : sp;
    c = (float)cc; s = (float)ss;
}
__device__ __forceinline__ void p0_prologue(Frame& F) {
    LAS float* scr = (LAS float*)(F.lds + RING_OFF + F.wave * 16384);
    const int gw = blockIdx.x * NWAVES + F.wave, NGW = F.G * NWAVES;
    const int gt = blockIdx.x * (NWAVES * 64) + F.tid, NGT = F.G * NWAVES * 64;
    bf16* Win = (bf16*)(F.ws + WS_WIN); bf16* Wout = (bf16*)(F.ws + WS_WOUT); bf16* Wup = (bf16*)(F.ws + WS_WUP); bf16* Wdn = (bf16*)(F.ws + WS_WDN);
    { float* rope = (float*)(F.ws + WS_ROPE);
      for (int e = gt; e < (SEQ + 1) * 8; e += NGT) { const int p = e >> 3, i = e & 7; const float pos = (p < SEQ) ? (float)p : 16384.0f;
          const float invf[8] = {1.0f, 0.19392274474868576f, 0.03760603093086393f, 0.007292664737217109f, 0.001414213562373095f, 0.0002742481756762073f, 5.318295896944988e-05f, 1.031338537721246e-05f};
          float fsel = invf[0];
#pragma unroll
          for (int k = 1; k < 8; ++k) fsel = (i == k) ? invf[k] : fsel;
          const float ang = pos * fsel; float c, s; sincos_acc(ang, c, s); rope[p * 16 + i] = c; rope[p * 16 + 8 + i] = s; }
      float* bperm = (float*)(F.ws + WS_BPERM); const float* b_in = F.in[7];
      for (int n = gt; n < IN_DIM; n += NGT) bperm[inproj_row(n)] = b_in[n];
      float* rs = (float*)(F.ws + WS_ROWSS); float* rs2 = (float*)(F.ws + WS_ROWSS2);
      for (int r = gt; r < RPAD; r += NGT) { rs[r] = 0.f; rs2[r] = 0.f; } }
    constexpr int I_IN = (DM / 64) * (IN_DIM / 32), I_OUT = (DM / 64) * (DM / 32), I_UP = (DM / 64) * (DFF / 32), I_DN = (DFF / 64) * (DM / 32);
    constexpr int NITEMS = I_IN + I_OUT + I_UP + I_DN;
    for (int it = gw; it < NITEMS; it += NGW) {
        int r = it;
        if (r < I_IN) { const int nblk = IN_DIM / 32, kb = r / nblk, nb = r % nblk; p0_transpose_item(F.in[6], DM, IN_DIM, Win, 64 * kb, 32 * nb, inproj_row(32 * nb), nullptr, scr, F.lane); continue; } r -= I_IN;
        if (r < I_OUT) { const int nblk = DM / 32, kb = r / nblk, nb = r % nblk; p0_transpose_item(F.in[13], DM, DM, Wout, 64 * kb, 32 * nb, 32 * nb, nullptr, scr, F.lane); continue; } r -= I_OUT;
        if (r < I_UP) { const int nblk = DFF / 32, kb = r / nblk, nb = r % nblk; p0_transpose_item(F.in[16], DM, DFF, Wup, 64 * kb, 32 * nb, 32 * nb, F.in[15], scr, F.lane); continue; } r -= I_UP;
        { const int nblk = DM / 32, kb = r / nblk, nb = r % nblk; p0_transpose_item(F.in[17], DFF, DM, Wdn, 64 * kb, 32 * nb, 32 * nb, nullptr, scr, F.lane); }
    }
    bf16* XN = (bf16*)(F.ws + WS_A); const float* g1 = F.in[5];
    for (int m0 = gw; m0 < MR; m0 += 2 * NGW) {
        const int m1 = m0 + NGW; const bool has1 = m1 < MR; const int m1c = has1 ? m1 : m0;
        const f32x4* xa = (const f32x4*)(m0 < MP ? F.in[0] + (size_t)m0 * DM : F.in[1] + (size_t)(m0 - MP) * DM) + F.lane;
        const f32x4* xb = (const f32x4*)(m1c < MP ? F.in[0] + (size_t)m1c * DM : F.in[1] + (size_t)(m1c - MP) * DM) + F.lane;
        f32x4 va[8], vb[8]; float sa = 0.f, sb = 0.f;
#pragma unroll
        for (int j = 0; j < 8; ++j) { va[j] = xa[64 * j]; vb[j] = xb[64 * j]; }
#pragma unroll
        for (int j = 0; j < 8; ++j) { sa += (va[j].x * va[j].x + va[j].y * va[j].y) + (va[j].z * va[j].z + va[j].w * va[j].w); sb += (vb[j].x * vb[j].x + vb[j].y * vb[j].y) + (vb[j].z * vb[j].z + vb[j].w * vb[j].w); }
        const float ra = 1.0f / sqrtf(wave_sum(sa) * (1.0f / DM) + EPS), rb = 1.0f / sqrtf(wave_sum(sb) * (1.0f / DM) + EPS);
        v2u* oa = (v2u*)(XN + (size_t)m0 * DM) + F.lane; v2u* ob = (v2u*)(XN + (size_t)m1c * DM) + F.lane;
#pragma unroll
        for (int j = 0; j < 8; ++j) { const f32x4 g = *((const f32x4*)g1 + F.lane + 64 * j);
            oa[64 * j] = (v2u){pk2(va[j].x * ra * g.x, va[j].y * ra * g.y), pk2(va[j].z * ra * g.z, va[j].w * ra * g.w)};
            if (has1) ob[64 * j] = (v2u){pk2(vb[j].x * rb * g.x, vb[j].y * rb * g.y), pk2(vb[j].z * rb * g.z, vb[j].w * rb * g.w)}; }
    }
}

#define MFMA32(a, b, c) __builtin_amdgcn_mfma_f32_32x32x16_bf16((a), (b), (c), 0, 0, 0)
__device__ __forceinline__ int crow(int r, int hi) { return (r & 3) + 8 * (r >> 2) + 4 * hi; }

#define SCHED_BAR() __builtin_amdgcn_sched_barrier(0)
constexpr int ATT_BUF = 49152, ATT_VOFF = 24576;
__device__ __forceinline__ void attn_dma_unit(int u, const bf16* Kp, const bf16* Vp, LAS unsigned char* buf, int wave, int lane) {
    const int pair = u & 31, kvh = (u >> 5) & 3, b = u >> 7, kblk0 = 2 * pair - 4;
    const size_t plane = (size_t)(b * 4 + kvh) * (SEQ * 64);
#pragma unroll
    for (int i = 0; i < 6; ++i) {
        const int p = wave + 8 * i;
        const int isv = p >= 24, pp = isv ? p - 24 : p;
        int kb = kblk0 + (pp >> 2); kb = kb > 0 ? kb : 0;
        const bf16* g = (isv ? Vp : Kp) + plane + (size_t)kb * 2048 + (pp & 3) * 512 + lane * 8;
        __builtin_amdgcn_global_load_lds((const unsigned*)g, (LAS unsigned*)(buf + (isv ? ATT_VOFF : 0) + pp * 1024), 16, 0, 0);
    }
}
__device__ __forceinline__ void attn_phase(Frame& F, const bf16* Q, const bf16* Kp, const bf16* Vp, bf16* mix) {
    const int lane = F.lane, wave = F.wave, r32 = lane & 31, hi = lane >> 5, hl = wave & 3, qsel = wave >> 2;
    const int NU = NBATCH * 4 * 32;
    int u = blockIdx.x;
    if (u >= NU) return;
    LAS unsigned char* lbase = F.lds + RING_OFF;
    attn_dma_unit(u, Kp, Vp, lbase, wave, lane);
    bf16x8 qf[4];
    { const int pair = u & 31, kvh = (u >> 5) & 3, b = u >> 7; const bf16* qp = Q + (size_t)(b * 16 + kvh * 4 + hl) * (SEQ * 64) + (size_t)(2 * pair + qsel) * 2048 + lane * 8;
#pragma unroll
      for (int d0 = 0; d0 < 4; ++d0) qf[d0] = *(const bf16x8*)(qp + d0 * 512); }
    v4u held[4]; bf16* hptr = nullptr;
    LAS unsigned char* wst = lbase + 2 * ATT_BUF + wave * 4352;
    LAS float* wsf = (LAS float*)(wst + 4096);
    int it = 0;
    for (; u < NU; u += F.G, ++it) {
        const int pair = u & 31, kvh = (u >> 5) & 3, b = u >> 7, h = kvh * 4 + hl, qb = 2 * pair + qsel, kb0 = qb - 4;
        asm volatile("s_waitcnt vmcnt(0)" ::: "memory"); __builtin_amdgcn_s_barrier(); asm volatile("" ::: "memory");
        if (hptr) {
#pragma unroll
            for (int i = 0; i < 4; ++i) *(v4u*)(hptr + (size_t)(i * 8) * DM) = held[i];
        }
        const int un = u + F.G;
        LAS unsigned char* buf = lbase + (it & 1) * ATT_BUF;
        if (un < NU) attn_dma_unit(un, Kp, Vp, lbase + ((it + 1) & 1) * ATT_BUF, wave, lane);
        const float sink2 = F.in[8][h] * LOG2E;
        f32x16 S[5];
#pragma unroll
        for (int jb = 0; jb < 5; ++jb) {
            const LAS unsigned char* kp = buf + (qsel + jb) * 4096 + lane * 16;
            f32x16 a;
#pragma unroll
            for (int r = 0; r < 16; ++r) a[r] = 0.f;
#pragma unroll
            for (int d0 = 0; d0 < 4; ++d0) a = MFMA32(*(const LAS bf16x8*)(kp + d0 * 1024), qf[d0], a);
            S[jb] = a;
        }
        SCHED_BAR();
        if (un < NU) { const int pn = un & 31, kn = (un >> 5) & 3, bn = un >> 7; const bf16* qp = Q + (size_t)(bn * 16 + kn * 4 + hl) * (SEQ * 64) + (size_t)(2 * pn + qsel) * 2048 + lane * 8;
#pragma unroll
            for (int d0 = 0; d0 < 4; ++d0) qf[d0] = *(const bf16x8*)(qp + d0 * 512); }
        float mx = sink2;
#pragma unroll
        for (int jb = 0; jb < 5; ++jb) {
            const bool blk_ok = (kb0 + jb) >= 0;
#pragma unroll
            for (int r = 0; r < 16; ++r) {
                float x = S[jb][r] * C2;
                bool ok = blk_ok;
                if (jb == 0) ok = ok && (crow(r, hi) > r32);
                if (jb == 4) ok = ok && (crow(r, hi) <= r32);
                x = ok ? x : -INFINITY;
                S[jb][r] = x; mx = fmaxf(mx, x);
            }
        }
        mx = fmaxf(mx, __shfl_xor(mx, 32));
        float l = 0.f;
#pragma unroll
        for (int jb = 0; jb < 5; ++jb)
#pragma unroll
            for (int r = 0; r < 16; ++r) { const float pv = __builtin_amdgcn_exp2f(S[jb][r] - mx); S[jb][r] = pv; l += pv; }
        l += __shfl_xor(l, 32);
        l += __builtin_amdgcn_exp2f(sink2 - mx);
        f32x16 o[2];
#pragma unroll
        for (int r = 0; r < 16; ++r) { o[0][r] = 0.f; o[1][r] = 0.f; }
#pragma unroll
        for (int jb = 0; jb < 5; ++jb) {
            const LAS unsigned char* vp = buf + ATT_VOFF + (qsel + jb) * 4096 + lane * 16;
#pragma unroll
            for (int sx = 0; sx < 2; ++sx) {
                v4u pw; pw.x = pk2(S[jb][8 * sx + 0], S[jb][8 * sx + 1]); pw.y = pk2(S[jb][8 * sx + 2], S[jb][8 * sx + 3]); pw.z = pk2(S[jb][8 * sx + 4], S[jb][8 * sx + 5]); pw.w = pk2(S[jb][8 * sx + 6], S[jb][8 * sx + 7]);
                const bf16x8 pf = __builtin_bit_cast(bf16x8, pw);
#pragma unroll
                for (int db = 0; db < 2; ++db) o[db] = MFMA32(pf, *(const LAS bf16x8*)(vp + (db * 2 + sx) * 1024), o[db]);
            }
        }
        if (hi == 0) wsf[r32] = 1.0f / l;
        asm volatile("s_waitcnt lgkmcnt(0)" ::: "memory");
#pragma unroll
        for (int r = 0; r < 16; ++r) { const float li = wsf[crow(r, hi)]; const int q = crow(r, hi);
#pragma unroll
            for (int db = 0; db < 2; ++db) ((LAS bf16*)wst)[q * 64 + db * 32 + r32] = (bf16)(pk2(o[db][r] * li, 0.f) & 0xffffu); }
        asm volatile("s_waitcnt lgkmcnt(0)" ::: "memory");
#pragma unroll
        for (int i = 0; i < 4; ++i) held[i] = *(const LAS v4u*)(wst + (i * 8 + (lane >> 3)) * 128 + (lane & 7) * 16);
        hptr = mix + ((size_t)b * SEQ + qb * 32 + (lane >> 3)) * DM + h * 64 + (lane & 7) * 8;
    }
    if (hptr) {
#pragma unroll
        for (int i = 0; i < 4; ++i) *(v4u*)(hptr + (size_t)(i * 8) * DM) = held[i];
    }
    asm volatile("s_waitcnt vmcnt(0) lgkmcnt(0)" ::: "memory"); __builtin_amdgcn_s_barrier(); asm volatile("" ::: "memory");
}

__device__ __forceinline__ void sample_attn_unit(int sb, int kvh, const Frame& F, const bf16* Q, bf16* mix) {
    const int lane = F.lane, ks = lane >> 4, dq = lane & 15;
    const float* cache_k = F.in[2]; const float* cache_v = F.in[3];
    float* sk = F.out + O_SK; float* sv = F.out + O_SV;
    f32x4 qv[4]; float sink2[4];
#pragma unroll
    for (int g = 0; g < 4; ++g) { const v2u qq = *(const v2u*)(Q + (size_t)(MP + sb) * QD + (kvh * 4 + g) * 64 + dq * 4);
        qv[g] = (f32x4){bf_lo(qq.x), bf_hi(qq.x), bf_lo(qq.y), bf_hi(qq.y)}; sink2[g] = F.in[8][kvh * 4 + g] * LOG2E; }
    float sc[4][2];
#pragma unroll
    for (int g = 0; g < 4; ++g) { sc[g][0] = 0.f; sc[g][1] = 0.f; }
#pragma unroll
    for (int slot = 0; slot < 2; ++slot) {
#pragma unroll 1
        for (int half = 0; half < 2; ++half) {
            f32x4 kv[8];
#pragma unroll
            for (int ii = 0; ii < 8; ++ii) { const int j = 4 * (slot * 16 + half * 8 + ii) + ks;
                const float* kr = (j < 127) ? cache_k + ((size_t)(sb * 128 + j + 1) * 4 + kvh) * 64 : sk + ((size_t)(sb * 128 + 127) * 4 + kvh) * 64;
                kv[ii] = *(const f32x4*)(kr + dq * 4); }
#pragma unroll
            for (int ii = 0; ii < 8; ++ii) { const int j = 4 * (slot * 16 + half * 8 + ii) + ks;
                if (j < 127) *(f32x4*)(sk + ((size_t)(sb * 128 + j) * 4 + kvh) * 64 + dq * 4) = kv[ii];
#pragma unroll
                for (int g = 0; g < 4; ++g) {
                    float d = (kv[ii].x * qv[g].x + kv[ii].y * qv[g].y) + (kv[ii].z * qv[g].z + kv[ii].w * qv[g].w);
                    d += __shfl_xor(d, 1); d += __shfl_xor(d, 2); d += __shfl_xor(d, 4); d += __shfl_xor(d, 8);
                    sc[g][slot] = (dq == half * 8 + ii) ? d * C2 : sc[g][slot];
                }
            }
        }
    }
    float pr[4][2], linv[4];
#pragma unroll
    for (int g = 0; g < 4; ++g) {
        const float mx = fmaxf(sink2[g], wave_max(fmaxf(sc[g][0], sc[g][1])));
        pr[g][0] = __builtin_amdgcn_exp2f(sc[g][0] - mx); pr[g][1] = __builtin_amdgcn_exp2f(sc[g][1] - mx);
        linv[g] = 1.0f / (wave_sum(pr[g][0] + pr[g][1]) + __builtin_amdgcn_exp2f(sink2[g] - mx));
    }
    f32x4 oacc[4];
#pragma unroll
    for (int g = 0; g < 4; ++g) oacc[g] = (f32x4){0.f, 0.f, 0.f, 0.f};
#pragma unroll
    for (int slot = 0; slot < 2; ++slot) {
#pragma unroll 1
        for (int half = 0; half < 2; ++half) {
            f32x4 vv[8];
#pragma unroll
            for (int ii = 0; ii < 8; ++ii) { const int j = 4 * (slot * 16 + half * 8 + ii) + ks;
                const float* vr = (j < 127) ? cache_v + ((size_t)(sb * 128 + j + 1) * 4 + kvh) * 64 : sv + ((size_t)(sb * 128 + 127) * 4 + kvh) * 64;
                vv[ii] = *(const f32x4*)(vr + dq * 4); }
#pragma unroll
            for (int ii = 0; ii < 8; ++ii) { const int j = 4 * (slot * 16 + half * 8 + ii) + ks;
                if (j < 127) *(f32x4*)(sv + ((size_t)(sb * 128 + j) * 4 + kvh) * 64 + dq * 4) = vv[ii];
#pragma unroll
                for (int g = 0; g < 4; ++g) { const float pj = __shfl(pr[g][slot], (lane & 48) | (half * 8 + ii)); oacc[g] += vv[ii] * pj; }
            }
        }
    }
#pragma unroll
    for (int g = 0; g < 4; ++g)
#pragma unroll
        for (int e = 0; e < 4; ++e) { float t = oacc[g][e]; t += __shfl_xor(t, 16); t += __shfl_xor(t, 32); oacc[g][e] = t * linv[g]; }
    f32x4 o = oacc[0];
#pragma unroll
    for (int g = 1; g < 4; ++g) o = (ks == g) ? oacc[g] : o;
    *(v2u*)(mix + (size_t)(MP + sb) * DM + (kvh * 4 + ks) * 64 + dq * 4) = (v2u){pk2(o.x, o.y), pk2(o.z, o.w)};
}

__device__ __forceinline__ void sample_conv_unit(int sb, const Frame& F, bf16* mix) {
    const int lane = F.lane;
    const float* cc = F.in[4] + (size_t)sb * 30 * CCH; const float* cw = F.in[9];
    float* sc = F.out + O_SC + (size_t)sb * 30 * CCH;
    f32x4 y[4];
    const int cl = lane * 4;
#pragma unroll
    for (int k = 0; k < 4; ++k) { const f32x4 uv = *(const f32x4*)(cc + cl + 256 * k); y[k] = *(const f32x4*)(F.in[10] + cl + 256 * k) + *(const f32x4*)(cw + cl + 256 * k) * uv; }
#pragma unroll 4
    for (int j = 1; j < 30; ++j) {
#pragma unroll
        for (int k = 0; k < 4; ++k) { const int c = cl + 256 * k; const f32x4 uv = *(const f32x4*)(cc + (size_t)j * CCH + c); y[k] += *(const f32x4*)(cw + (size_t)j * CCH + c) * uv; *(f32x4*)(sc + (size_t)(j - 1) * CCH + c) = uv; }
    }
#pragma unroll
    for (int k = 0; k < 4; ++k) { const int c = cl + 256 * k; y[k] += *(const f32x4*)(cw + (size_t)30 * CCH + c) * *(const f32x4*)(sc + (size_t)29 * CCH + c); }
    float s = 0.f;
#pragma unroll
    for (int k = 0; k < 4; ++k) s += (y[k].x + y[k].y) + (y[k].z + y[k].w);
    const float mu = wave_sum(s) * (1.0f / CCH);
    float q = 0.f;
#pragma unroll
    for (int k = 0; k < 4; ++k) { y[k] = y[k] - mu; q += (y[k].x * y[k].x + y[k].y * y[k].y) + (y[k].z * y[k].z + y[k].w * y[k].w); }
    const float rstd = 1.0f / sqrtf(wave_sum(q) * (1.0f / CCH) + EPS);
#pragma unroll
    for (int k = 0; k < 4; ++k) {
        const int c = lane * 4 + 256 * k;
        const f32x4 g = *(const f32x4*)(F.in[11] + c), bb = *(const f32x4*)(F.in[12] + c);
        f32x4 yn = y[k] * rstd * g + bb;
#pragma unroll
        for (int e = 0; e < 4; ++e) yn[e] = yn[e] * __builtin_amdgcn_rcpf(1.0f + __expf(-yn[e]));
        *(v2u*)(mix + (size_t)(MP + sb) * DM + QD + c) = (v2u){pk2(yn.x, yn.y), pk2(yn.z, yn.w)};
    }
}

typedef float f32x2 __attribute__((ext_vector_type(2)));
__device__ __forceinline__ void conv_prompt_unit(int b, int t0, const Frame& F, const bf16* U, bf16* mix, const f32x2 (&w)[CONVW], f32x2 cb, f32x2 lg, f32x2 lb) {
    const int c0 = 2 * F.tid;
    LAS float* red = (LAS float*)(F.lds + RING_OFF);
    const bf16* ub = U + (size_t)b * SEQ * CCH + c0;
    f32x2 win[38];
#pragma unroll
    for (int i = 0; i < 30; ++i) { const int t = t0 - 30 + i; const unsigned x = (t >= 0) ? *(const unsigned*)(ub + (size_t)t * CCH) : 0u; win[i] = (f32x2){bf_lo(x), bf_hi(x)}; }
    unsigned nx[8];
#pragma unroll
    for (int r = 0; r < 8; ++r) nx[r] = *(const unsigned*)(ub + (size_t)(t0 + r) * CCH);
    const int lane = F.lane;
    for (int bt = 0; bt < 16; ++bt) {
        const int tb = t0 + bt * 8;
#pragma unroll
        for (int r = 0; r < 8; ++r) win[30 + r] = (f32x2){bf_lo(nx[r]), bf_hi(nx[r])};
        if (bt + 1 < 16) {
#pragma unroll
            for (int r = 0; r < 8; ++r) nx[r] = *(const unsigned*)(ub + (size_t)(tb + 8 + r) * CCH);
        }
        f32x2 y[8]; float st[16];
#pragma unroll
        for (int r = 0; r < 8; ++r) {
            f32x2 a = cb;
#pragma unroll
            for (int j = 0; j < CONVW; ++j) a += w[j] * win[r + j];
            y[r] = a; const f32x2 a2 = a * a; st[2 * r] = a.x + a.y; st[2 * r + 1] = a2.x + a2.y;
        }
        { const bool b5 = lane & 32, b4 = lane & 16, b3 = lane & 8, b2 = lane & 4;
          float s8[8], s4[4], s2[2], s1;
#pragma unroll
          for (int k = 0; k < 8; ++k) { const float snd = b5 ? st[k] : st[k + 8], kp = b5 ? st[k + 8] : st[k]; s8[k] = kp + __shfl_xor(snd, 32); }
#pragma unroll
          for (int k = 0; k < 4; ++k) { const float snd = b4 ? s8[k] : s8[k + 4], kp = b4 ? s8[k + 4] : s8[k]; s4[k] = kp + __shfl_xor(snd, 16); }
#pragma unroll
          for (int k = 0; k < 2; ++k) { const float snd = b3 ? s4[k] : s4[k + 2], kp = b3 ? s4[k + 2] : s4[k]; s2[k] = kp + __shfl_xor(snd, 8); }
          { const float snd = b2 ? s2[0] : s2[1], kp = b2 ? s2[1] : s2[0]; s1 = kp + __shfl_xor(snd, 4); }
          s1 += __shfl_xor(s1, 2); s1 += __shfl_xor(s1, 1);
          LAS float* rb = red + (bt & 1) * 128;
          if ((lane & 3) == 0) rb[F.wave * 16 + (lane >> 2)] = s1;
          asm volatile("s_waitcnt lgkmcnt(0)" ::: "memory"); __builtin_amdgcn_s_barrier(); asm volatile("" ::: "memory");
          f32x4 t4[4];
#pragma unroll
          for (int k = 0; k < 4; ++k) t4[k] = *(const LAS f32x4*)(rb + 4 * k);
#pragma unroll
          for (int wv = 1; wv < 8; ++wv)
#pragma unroll
              for (int k = 0; k < 4; ++k) t4[k] += *(const LAS f32x4*)(rb + wv * 16 + 4 * k);
#pragma unroll
          for (int k = 0; k < 16; ++k) st[k] = t4[k >> 2][k & 3];
        }
#pragma unroll
        for (int r = 0; r < 8; ++r) {
            const float mu = st[2 * r] * (1.0f / CCH), var = fmaxf(st[2 * r + 1] * (1.0f / CCH) - mu * mu, 0.f), rstd = __builtin_amdgcn_rsqf(var + EPS);
            f32x2 a = (y[r] - mu) * (lg * rstd) + lb;
            a.x = a.x * __builtin_amdgcn_rcpf(1.0f + __expf(-a.x)); a.y = a.y * __builtin_amdgcn_rcpf(1.0f + __expf(-a.y));
            *(unsigned*)(mix + ((size_t)b * SEQ + tb + r) * DM + QD + c0) = pk2(a.x, a.y);
        }
#pragma unroll
        for (int i = 0; i < 30; ++i) win[i] = win[i + 8];
    }
    asm volatile("s_waitcnt lgkmcnt(0)" ::: "memory"); __builtin_amdgcn_s_barrier(); asm volatile("" ::: "memory");
}

__device__ __forceinline__ void p2_mixers(Frame& F, int mask) {
    const bf16* Q = (const bf16*)(F.ws + WS_Q); const bf16* Kb = (const bf16*)(F.ws + WS_K); const bf16* Vp = (const bf16*)(F.ws + WS_V); const bf16* U = (const bf16*)(F.ws + WS_U);
    bf16* mix = (bf16*)(F.ws + WS_A);
    if (mask & 1) {
        const int c0 = 2 * F.tid;
        f32x2 w[CONVW];
#pragma unroll
        for (int j = 0; j < CONVW; ++j) w[j] = *(const f32x2*)(F.in[9] + (size_t)j * CCH + c0);
        const f32x2 cb = *(const f32x2*)(F.in[10] + c0), lg = *(const f32x2*)(F.in[11] + c0), lb = *(const f32x2*)(F.in[12] + c0);
        for (int unit = blockIdx.x; unit < NBATCH * 16; unit += F.G) conv_prompt_unit(unit >> 4, (unit & 15) * 128, F, U, mix, w, cb, lg, lb);
    }
    const int gw = blockIdx.x * NWAVES + F.wave, NGW = F.G * NWAVES;
    if (mask & 2) attn_phase(F, Q, Kb, Vp, mix);
    if ((mask & 4) && F.wave >= 5 && F.wave < 7) for (int su = blockIdx.x * 2 + (F.wave - 5); su < MS * 4; su += F.G * 2) sample_attn_unit(su >> 2, su & 3, F, Q, mix);
    if ((mask & 8) && F.wave == 7) for (int su = blockIdx.x; su < MS; su += F.G) sample_conv_unit(su, F, mix);
}


#define MFMA16(a, b, c) __builtin_amdgcn_mfma_f32_16x16x32_bf16((a), (b), (c), 0, 0, 0)
template <int NT, int BS>
__device__ __forceinline__ void skinny_wave(const bf16* A, int lda, const bf16* Bt, int ldb, const int (&brow)[NT], int k0, int klen, int R0, int lane, f32x4 (&acc)[NT]) {
    const int fr = lane & 15, fq = lane >> 4;
    const bf16* ap = A + (size_t)(R0 + fr) * lda + k0 + fq * 8;
    const bf16* bp[NT];
#pragma unroll
    for (int t = 0; t < NT; ++t) { bp[t] = Bt + (size_t)(brow[t] + fr) * ldb + k0 + fq * 8; acc[t] = (f32x4){0.f, 0.f, 0.f, 0.f}; }
    bf16x8 a[2][BS], bb[2][NT][BS];
#define SK_LOAD(buf, kk) do { _Pragma("unroll") for (int i_ = 0; i_ < BS; ++i_) { a[buf][i_] = *(const bf16x8*)(ap + (kk) + 32 * i_); \
        _Pragma("unroll") for (int t_ = 0; t_ < NT; ++t_) bb[buf][t_][i_] = *(const bf16x8*)(bp[t_] + (kk) + 32 * i_); } } while (0)
#define SK_MMA(buf) do { _Pragma("unroll") for (int i_ = 0; i_ < BS; ++i_) _Pragma("unroll") for (int t_ = 0; t_ < NT; ++t_) acc[t_] = MFMA16(a[buf][i_], bb[buf][t_][i_], acc[t_]); } while (0)
    const int bstep = 32 * BS, nb = klen / bstep;
    SK_LOAD(0, 0);
    for (int kb = 0; kb < nb; kb += 2) {
        SK_LOAD(1, (kb + 1) * bstep); SCHED_BAR(); SK_MMA(0); SCHED_BAR();
        const int nk = (kb + 2 < nb) ? (kb + 2) * bstep : 0;
        SK_LOAD(0, nk); SCHED_BAR(); SK_MMA(1); SCHED_BAR();
    }
#undef SK_LOAD
#undef SK_MMA
}
__device__ __forceinline__ bf16 f2bf1(float v) { return (bf16)(pk2(v, 0.f) & 0xffffu); }

__device__ __forceinline__ void p1_sample(Frame& F) {
    const bf16* XN = (const bf16*)(F.ws + WS_A); const bf16* Win = (const bf16*)(F.ws + WS_WIN);
    const float* bperm = (const float*)(F.ws + WS_BPERM); const float* ropeS = (const float*)(F.ws + WS_ROPE) + (size_t)SEQ * 16;
    bf16* Q = (bf16*)(F.ws + WS_Q);
    const int lane = F.lane, fr = lane & 15, fq = lane >> 4, R0 = MP + 16 * F.wave;
    for (int job = blockIdx.x; job < 160; job += F.G) {
        if (job < 96) {
            const int zc0 = (job < 80) ? job * 16 : 1280 + (job - 80) * 16;
            const int brow[1] = {zc0}; f32x4 acc[1];
            skinny_wave<1, 8>(XN, DM, Win, DM, brow, 0, DM, R0, lane, acc);
            const float bias = bperm[zc0 + fr];
            const bool rope = (job < 80) && ((job & 3) == 0);
            const float rc = ropeS[fr & 7], rs = ropeS[8 + (fr & 7)];
#pragma unroll
            for (int i = 0; i < 4; ++i) {
                const int sb = 16 * F.wave + 4 * fq + i;
                float v = acc[0][i] + bias;
                if (rope) { const float p = __shfl_xor(v, 8); v = (fr < 8) ? v * rc - p * rs : v * rc + p * rs; }
                if (job < 64) Q[(size_t)(MP + sb) * QD + zc0 + fr] = f2bf1(v);
                else if (job < 80) F.out[O_SK + ((size_t)sb * 128 + 127) * KVD + (zc0 - 1024) + fr] = v;
                else F.out[O_SV + ((size_t)sb * 128 + 127) * KVD + (zc0 - 1280) + fr] = v;
            }
        } else {
            const int c0 = (job - 96) * 16, r0 = 1536 + (c0 >> 7) * 256 + (c0 & 127);
            const int brow[2] = {r0, r0 + 128}; f32x4 acc[2];
            skinny_wave<2, 4>(XN, DM, Win, DM, brow, 0, DM, R0, lane, acc);
            const float bv = bperm[r0 + fr], bg = bperm[r0 + 128 + fr];
#pragma unroll
            for (int i = 0; i < 4; ++i) {
                const int sb = 16 * F.wave + 4 * fq + i;
                const float val = acc[0][i] + bv, gate = acc[1][i] + bg;
                F.out[O_SC + ((size_t)sb * 30 + 29) * CCH + c0 + fr] = val * __builtin_amdgcn_rcpf(1.0f + __expf(-gate));
            }
        }
    }
}
__device__ __forceinline__ void p3_sample(Frame& F) {
    const bf16* mix = (const bf16*)(F.ws + WS_A); const bf16* Wout = (const bf16*)(F.ws + WS_WOUT); bf16* HB = (bf16*)(F.ws + WS_HB);
    float* rowss = (float*)(F.ws + WS_ROWSS);
    const int lane = F.lane, fr = lane & 15, fq = lane >> 4, R0 = MP + 16 * F.wave;
    for (int job = blockIdx.x; job < 128; job += F.G) {
        const int brow[1] = {job * 16}; f32x4 acc[1];
        skinny_wave<1, 8>(mix, DM, Wout, DM, brow, 0, DM, R0, lane, acc);
        const int col = job * 16 + fr; const float bias = F.in[14][col];
#pragma unroll
        for (int i = 0; i < 4; ++i) {
            const int sb = 16 * F.wave + 4 * fq + i;
            const float v = acc[0][i] + bias + F.in[1][(size_t)sb * DM + col];
            HB[(size_t)(MP + sb) * DM + col] = f2bf1(v);
            float ss = v * v; ss += __shfl_xor(ss, 1); ss += __shfl_xor(ss, 2); ss += __shfl_xor(ss, 4); ss += __shfl_xor(ss, 8);
            if (fr == 0) unsafeAtomicAdd(rowss + MP + sb, ss);
        }
    }
}
__device__ __forceinline__ void p4_sample(Frame& F) {
    const bf16* HB = (const bf16*)(F.ws + WS_HB); const bf16* Wup = (const bf16*)(F.ws + WS_WUP); bf16* ACT = (bf16*)(F.ws + WS_ACT);
    const float* rowss = (const float*)(F.ws + WS_ROWSS);
    const int lane = F.lane, fr = lane & 15, fq = lane >> 4, R0 = MP + 16 * F.wave;
    for (int job = blockIdx.x; job < 256; job += F.G) {
        const int brow[2] = {job * 32, job * 32 + 16}; f32x4 acc[2];
        skinny_wave<2, 4>(HB, DM, Wup, DM, brow, 0, DM, R0, lane, acc);
#pragma unroll
        for (int i = 0; i < 4; ++i) {
            const int sb = 16 * F.wave + 4 * fq + i;
            const float rr = 1.0f / (rowss[MP + sb] * (1.0f / DM) + EPS);
#pragma unroll
            for (int t = 0; t < 2; ++t) { const float a = fmaxf(acc[t][i], 0.f); ACT[(size_t)(MP + sb) * DFF + brow[t] + fr] = f2bf1(a * a * rr); }
        }
    }
}
__device__ __forceinline__ void p5_sample(Frame& F) {
    const bf16* ACT = (const bf16*)(F.ws + WS_ACT); const bf16* Wdn = (const bf16*)(F.ws + WS_WDN); float* part = (float*)(F.ws + WS_PART);
    const int lane = F.lane, fr = lane & 15, fq = lane >> 4, R0 = MP + 16 * F.wave;
    for (int job = blockIdx.x; job < 256; job += F.G) {
        const int ct = job & 127, kh = job >> 7;
        const int brow[1] = {ct * 16}; f32x4 acc[1];
        skinny_wave<1, 8>(ACT, DFF, Wdn, DFF, brow, kh * (DFF / 2), DFF / 2, R0, lane, acc);
#pragma unroll
        for (int i = 0; i < 4; ++i) { const int sb = 16 * F.wave + 4 * fq + i; part[((size_t)kh * MS + sb) * DM + ct * 16 + fr] = acc[0][i]; }
    }
}

__device__ __forceinline__ void p6_final(Frame& F) {
    const int gw = blockIdx.x * NWAVES + F.wave, NGW = F.G * NWAVES;
    const float* rs2 = (const float*)(F.ws + WS_ROWSS2); const float* gf = F.in[18];
    const bf16* YB = (const bf16*)(F.ws + WS_A); const bf16* HB = (const bf16*)(F.ws + WS_HB);
    {
        f32x4 g[8];
#pragma unroll
        for (int j = 0; j < 4; ++j) { g[2 * j] = *(const f32x4*)(gf + (j * 64 + F.lane) * 8); g[2 * j + 1] = *(const f32x4*)(gf + (j * 64 + F.lane) * 8 + 4); }
        for (int m = gw; m < MP; m += 2 * NGW) {
            const int mB = (m + NGW < MP) ? m + NGW : m;
            const float rA = 1.0f / sqrtf(rs2[m] * (1.0f / DM) + EPS), rB = 1.0f / sqrtf(rs2[mB] * (1.0f / DM) + EPS);
            const v4u* yA = (const v4u*)(YB + (size_t)m * DM) + F.lane; const v4u* yB = (const v4u*)(YB + (size_t)mB * DM) + F.lane;
            float* oA = F.out + (size_t)m * DM + F.lane * 8; float* oB = F.out + (size_t)mB * DM + F.lane * 8;
            v4u ya[4], yb[4];
#pragma unroll
            for (int j = 0; j < 4; ++j) { ya[j] = yA[64 * j]; yb[j] = yB[64 * j]; }
#pragma unroll
            for (int j = 0; j < 4; ++j) {
                { const f32x4 a = (f32x4){bf_lo(ya[j].x), bf_hi(ya[j].x), bf_lo(ya[j].y), bf_hi(ya[j].y)}, c = (f32x4){bf_lo(ya[j].z), bf_hi(ya[j].z), bf_lo(ya[j].w), bf_hi(ya[j].w)};
                  *(f32x4*)(oA + j * 512) = a * rA * g[2 * j]; *(f32x4*)(oA + j * 512 + 4) = c * rA * g[2 * j + 1]; }
                if (mB != m) { const f32x4 a = (f32x4){bf_lo(yb[j].x), bf_hi(yb[j].x), bf_lo(yb[j].y), bf_hi(yb[j].y)}, c = (f32x4){bf_lo(yb[j].z), bf_hi(yb[j].z), bf_lo(yb[j].w), bf_hi(yb[j].w)};
                  *(f32x4*)(oB + j * 512) = a * rB * g[2 * j]; *(f32x4*)(oB + j * 512 + 4) = c * rB * g[2 * j + 1]; }
            }
        }
    }
    for (int sb = NGW - 1 - gw; sb < MS; sb += NGW) {
        f32x4* xr = (f32x4*)(F.out + (size_t)(MP + sb) * DM) + F.lane;
        const v2u* hr = (const v2u*)(HB + (size_t)(MP + sb) * DM) + F.lane;
        const f32x4* p0 = (const f32x4*)((const float*)(F.ws + WS_PART) + (size_t)sb * DM) + F.lane;
        const f32x4* p1 = (const f32x4*)((const float*)(F.ws + WS_PART) + (size_t)(MS + sb) * DM) + F.lane;
        f32x4 v[8]; float s = 0.f;
#pragma unroll
        for (int j = 0; j < 8; ++j) { const v2u hh = hr[64 * j]; v[j] = (f32x4){bf_lo(hh.x), bf_hi(hh.x), bf_lo(hh.y), bf_hi(hh.y)} + p0[64 * j] + p1[64 * j]; s += (v[j].x * v[j].x + v[j].y * v[j].y) + (v[j].z * v[j].z + v[j].w * v[j].w); }
        const float r = 1.0f / sqrtf(wave_sum(s) * (1.0f / DM) + EPS);
#pragma unroll
        for (int j = 0; j < 8; ++j) xr[64 * j] = v[j] * r * *((const f32x4*)gf + F.lane + 64 * j);
    }
}

constexpr int NPHASE = 7;
struct Args { const float* in[19]; float* out; unsigned char* ws; int ph_lo, ph_hi, p2mask, pad; };
__global__ void __launch_bounds__(NWAVES * 64, 2) mk_fwd(Args args) {
    extern __shared__ __attribute__((aligned(16))) unsigned char lds[];
    Frame F;
    F.lds = (LAS unsigned char*)lds;
    F.tid = threadIdx.x; F.lane = F.tid & 63; F.wave = __builtin_amdgcn_readfirstlane(F.tid >> 6); F.G = gridDim.x;
#pragma unroll
    for (int i = 0; i < 19; ++i) F.in[i] = args.in[i];
    F.out = args.out; F.ws = args.ws;
    const int lo = args.ph_lo, hi = args.ph_hi;
#define IN(k) (lo <= (k) && (k) < hi)
#define SEAM(k) do { if (IN(k) && IN((k) + 1)) { cg::this_grid().sync(); } } while (0)
    bf16* Win = (bf16*)(F.ws + WS_WIN); bf16* Wout = (bf16*)(F.ws + WS_WOUT); bf16* Wup = (bf16*)(F.ws + WS_WUP); bf16* Wdn = (bf16*)(F.ws + WS_WDN);
    bf16* XA = (bf16*)(F.ws + WS_A); bf16* HB = (bf16*)(F.ws + WS_HB); bf16* ACT = (bf16*)(F.ws + WS_ACT);
    float* rowss = (float*)(F.ws + WS_ROWSS); float* rowss2 = (float*)(F.ws + WS_ROWSS2);

    if (IN(0)) { p0_prologue(F); }
    SEAM(0);
    if (IN(1)) {
        pg8::Gemm g{XA, Win, MP, IN_DIM, DM}; pg8::StaticOrder S; S.init(MP, IN_DIM, F.G, (int)blockIdx.x);
        pg8::EpiIn E{(bf16*)(F.ws + WS_Q), (bf16*)(F.ws + WS_K), (bf16*)(F.ws + WS_V), (bf16*)(F.ws + WS_U), (const float*)(F.ws + WS_BPERM), (const float*)(F.ws + WS_ROPE), F.out};
        pg8::gemm_phase<pg8::EpiIn, pg8::StaticOrder, true, true>(F.lds + RING_OFF, g, S, E);
        p1_sample(F);
    }
    SEAM(1);
    if (IN(2)) { p2_mixers(F, args.p2mask); }
    SEAM(2);
    if (IN(3)) {
        pg8::Gemm g{XA, Wout, MP, DM, DM}; pg8::StaticOrder S; S.init(MP, DM, F.G, (int)blockIdx.x);
        pg8::EpiOut E{F.in[0], F.in[14], HB, rowss};
        pg8::gemm_phase<pg8::EpiOut, pg8::StaticOrder, true, true>(F.lds + RING_OFF, g, S, E);
        p3_sample(F);
    }
    SEAM(3);
    if (IN(4)) {
        pg8::Gemm g{HB, Wup, MP, DFF, DM}; pg8::StaticOrder S; S.init(MP, DFF, F.G, (int)blockIdx.x);
        pg8::EpiUp E{ACT, rowss};
        pg8::gemm_phase<pg8::EpiUp, pg8::StaticOrder, true, true>(F.lds + RING_OFF, g, S, E);
        p4_sample(F);
    }
    SEAM(4);
    if (IN(5)) {
        pg8::Gemm g{ACT, Wdn, MP, DM, DFF}; pg8::StaticOrder S; S.init(MP, DM, F.G, (int)blockIdx.x);
        pg8::EpiDown E{HB, XA, rowss2};
        pg8::gemm_phase<pg8::EpiDown, pg8::StaticOrder, true, true>(F.lds + RING_OFF, g, S, E);
        p5_sample(F);
    }
    SEAM(5);
    if (IN(6)) { p6_final(F); }
#undef IN
#undef SEAM
}

extern "C" void kernel_launch(void* const* d_in, const int* in_sizes, int n_in, void* d_out, int out_size, void* d_ws, size_t ws_size, hipStream_t stream) {
    static int grid = 0;
    if (grid == 0) {
        int dev = 0, cus = 0, per_cu = 0;
        (void)hipGetDevice(&dev);
        (void)hipDeviceGetAttribute(&cus, hipDeviceAttributeMultiprocessorCount, dev);
        if (hipFuncSetAttribute((const void*)mk_fwd, hipFuncAttributeMaxDynamicSharedMemorySize, LDS_BYTES) != hipSuccess) fprintf(stderr, "kernel_launch: hipFuncSetAttribute failed\n");
        if (hipOccupancyMaxActiveBlocksPerMultiprocessor(&per_cu, (const void*)mk_fwd, NWAVES * 64, LDS_BYTES) != hipSuccess || per_cu < 1) per_cu = 1;
        (void)hipGetLastError();
        if (cus <= 0) cus = 256;
        grid = cus * per_cu;
        if (n_in != 19 || ws_size < 1024 * MiB) fprintf(stderr, "kernel_launch: unexpected n_in %d / ws_size %zu\n", n_in, ws_size);
    }
    Args a{};
    for (int i = 0; i < 19; ++i) a.in[i] = (const float*)d_in[i];
    a.out = (float*)d_out; a.ws = (unsigned char*)d_ws; a.p2mask = 15;
#if MK_LAUNCHES == 1
    a.ph_lo = 0; a.ph_hi = NPHASE;
    void* params[] = {&a};
    hipError_t e = hipLaunchCooperativeKernel((const void*)mk_fwd, dim3(grid), dim3(NWAVES * 64), params, LDS_BYTES, stream);
    if (e != hipSuccess) fprintf(stderr, "cooperative launch failed: %s (grid %d)\n", hipGetErrorString(e), grid);
#else
    for (int p = 0; p < NPHASE; ++p) {
        a.ph_lo = p; a.ph_hi = p + 1;
        hipLaunchKernelGGL(mk_fwd, dim3(grid), dim3(NWAVES * 64), LDS_BYTES, stream, a);
        if (p == 2 && PROBE_REP > 0) { a.p2mask = PROBE_REP; hipLaunchKernelGGL(mk_fwd, dim3(grid), dim3(NWAVES * 64), LDS_BYTES, stream, a); a.p2mask = 15; }
    }
#endif
}
```
